# Optimizing an MI355X kernel written in HIP

```python
import math
import jax, jax.numpy as jnp
from jax import lax
import numpy as np

D_MODEL = 1024
BATCH = 32
SEQ = 2048
DEPTH = 4

GRID_W = 64
ROPE_THETA = 10000.0
Q_BLOCK = 128
CHUNK = 128
LN_EPS = 1e-5

A_HEADS = 4
A_QK_DIM = 32
A_V_DIM = 64
A_WIDTH = A_HEADS * A_V_DIM
B_HEADS = 8
B_KV_HEADS = 2
B_HEAD_DIM = 64
B_GROUP = B_HEADS // B_KV_HEADS
B_WIDTH = B_HEADS * B_HEAD_DIM
C_GROUPS = 4
C_GROUP_DIM = 64
C_WIDTH = C_GROUPS * C_GROUP_DIM
MIX_WIDTH = A_WIDTH + B_WIDTH + C_WIDTH

A_QK_COLS = A_HEADS * 2 * A_QK_DIM
B_KV_COLS = B_KV_HEADS * B_HEAD_DIM
IN_SPLITS = (A_QK_COLS, A_QK_COLS, A_WIDTH, B_WIDTH, B_KV_COLS, B_KV_COLS, C_WIDTH, C_WIDTH)
IN_COLS = sum(IN_SPLITS)
IN_OFFSETS = tuple(int(o) for o in np.cumsum(IN_SPLITS)[:-1])

FFN_HIDDEN = -(-8 * D_MODEL // (3 * 256)) * 256
DEEPNORM_ALPHA = (2 * DEPTH) ** 0.25
DEEPNORM_BETA = (8 * DEPTH) ** -0.25

kernel_name = 'hymba_style_diffattn_gqa_axial_gmlp_deepnorm_encoder'


def layer_norm(x, g, b):
    xf = x.astype(jnp.float32)
    mu = jnp.mean(xf, axis=-1, keepdims=True)
    var = jnp.mean(jnp.square(xf - mu), axis=-1, keepdims=True)
    return ((xf - mu) * lax.rsqrt(var + LN_EPS) * g.astype(jnp.float32) + b.astype(jnp.float32)).astype(x.dtype)


def rms_norm(x, g):
    xf = x.astype(jnp.float32)
    ms = jnp.mean(jnp.square(xf), axis=-1, keepdims=True)
    return (xf * lax.rsqrt(ms + LN_EPS) * g.astype(jnp.float32)).astype(x.dtype)


def rope_cos_sin(pos, dim):
    inv = 1.0 / (ROPE_THETA ** (jnp.arange(0, dim, 2, dtype=jnp.float32) / dim))
    ang = pos.astype(jnp.float32)[:, None] * inv[None, :]
    ang = jnp.concatenate([ang, ang], axis=-1)
    return jnp.cos(ang), jnp.sin(ang)


def rotate_half(x):
    x1, x2 = jnp.split(x, 2, axis=-1)
    return jnp.concatenate([-x2, x1], axis=-1)


def apply_rope(x, cos, sin):
    shape = (cos.shape[0],) + (1,) * (x.ndim - 3) + (cos.shape[1],)
    cos = cos.reshape(shape)
    sin = sin.reshape(shape)
    return (x * cos + rotate_half(x) * sin).astype(x.dtype)


def apply_axial_rope(x, cos_r, sin_r, cos_c, sin_c):
    x_row, x_col = jnp.split(x, 2, axis=-1)
    return jnp.concatenate([apply_rope(x_row, cos_r, sin_r), apply_rope(x_col, cos_c, sin_c)], axis=-1)


def sweep_query_blocks(fn, q):
    bsz, s = q.shape[:2]
    nb = s // Q_BLOCK
    qb = jnp.moveaxis(q.reshape((bsz, nb, Q_BLOCK) + q.shape[2:]), 1, 0)
    out = lax.map(fn, qb)
    out = jnp.moveaxis(out, 0, 1)
    return out.reshape((bsz, s) + out.shape[3:])


def diff_attention(q, k, v, lam):
    scale = A_QK_DIM ** -0.5

    def block(qb):
        s = jnp.einsum('bqhcd,bkhcd->bhcqk', qb, k).astype(jnp.float32) * scale
        p = jax.nn.softmax(s, axis=-1)
        w = (p[:, :, 0] - lam * p[:, :, 1]).astype(v.dtype)
        return jnp.einsum('bhqk,bkhd->bqhd', w, v)

    return sweep_query_blocks(block, q)


def gqa_attention(q, k, v):
    scale = B_HEAD_DIM ** -0.5

    def block(qb):
        s = jnp.einsum('bqhgd,bkhd->bhgqk', qb, k).astype(jnp.float32) * scale
        p = jax.nn.softmax(s, axis=-1).astype(v.dtype)
        return jnp.einsum('bhgqk,bkhd->bqhgd', p, v)

    return sweep_query_blocks(block, q)


def chunked_spatial_gating(u, v, w_s, b_s, g, beta):
    bsz, s, _ = v.shape
    v = layer_norm(v, g, beta)
    vc = v.reshape(bsz, s // CHUNK, CHUNK, C_GROUPS, C_GROUP_DIM)
    mixed = jnp.einsum('gpq,bnqgd->bnpgd', w_s, vc) + b_s.T[None, None, :, :, None]
    return u * mixed.reshape(bsz, s, C_WIDTH)


def setup_inputs(seed: int = 0) -> dict:
    key = jax.random.key(seed)
    ks = jax.random.split(key, 20)
    nrm = jax.random.normal
    f32 = jnp.float32

    def gain(k, shape):
        return 1.0 + 0.02 * nrm(k, shape, f32)

    def bias(k, shape):
        return 0.02 * nrm(k, shape, f32)

    return {
        'x': nrm(ks[0], (BATCH, SEQ, D_MODEL), f32),
        'w_in': nrm(ks[1], (DEPTH, D_MODEL, IN_COLS), f32) * D_MODEL ** -0.5,
        'w_out': nrm(ks[2], (DEPTH, MIX_WIDTH, D_MODEL), f32) * (MIX_WIDTH ** -0.5 * DEEPNORM_BETA),
        'lam_qk': 0.1 * nrm(ks[3], (DEPTH, 4, A_QK_DIM), f32),
        'a_subln_g': gain(ks[4], (DEPTH, A_V_DIM)),
        'b_q_norm_g': gain(ks[5], (DEPTH, B_HEAD_DIM)),
        'b_k_norm_g': gain(ks[6], (DEPTH, B_HEAD_DIM)),
        'c_ln_g': gain(ks[7], (DEPTH, C_WIDTH)),
        'c_ln_b': bias(ks[8], (DEPTH, C_WIDTH)),
        'c_w_s': nrm(ks[9], (DEPTH, C_GROUPS, CHUNK, CHUNK), f32) * CHUNK ** -0.5,
        'c_b_s': gain(ks[10], (DEPTH, C_GROUPS, CHUNK)),
        'ln1_g': gain(ks[11], (DEPTH, D_MODEL)),
        'ln1_b': bias(ks[12], (DEPTH, D_MODEL)),
        'w_gate': nrm(ks[13], (DEPTH, D_MODEL, FFN_HIDDEN), f32) * D_MODEL ** -0.5,
        'w_up': nrm(ks[14], (DEPTH, D_MODEL, FFN_HIDDEN), f32) * D_MODEL ** -0.5,
        'w_down': nrm(ks[15], (DEPTH, FFN_HIDDEN, D_MODEL), f32) * (FFN_HIDDEN ** -0.5 * DEEPNORM_BETA),
        'ln2_g': gain(ks[16], (DEPTH, D_MODEL)),
        'ln2_b': bias(ks[17], (DEPTH, D_MODEL)),
    }


def reference(x, w_in, w_out, lam_qk, a_subln_g, b_q_norm_g, b_k_norm_g, c_ln_g, c_ln_b,
              c_w_s, c_b_s, ln1_g, ln1_b, w_gate, w_up, w_down, ln2_g, ln2_b):
    bsz, s, _ = x.shape
    rows = s // GRID_W
    t = jnp.arange(s, dtype=jnp.int32)
    row_id = jnp.repeat(jnp.arange(rows, dtype=jnp.int32), GRID_W)
    col_id = jnp.tile(jnp.arange(GRID_W, dtype=jnp.int32), rows)
    cos_a, sin_a = rope_cos_sin(t, A_QK_DIM)
    cos_r, sin_r = rope_cos_sin(row_id, B_HEAD_DIM // 2)
    cos_c, sin_c = rope_cos_sin(col_id, B_HEAD_DIM // 2)

    for l in range(DEPTH):
        lam_init = 0.8 - 0.6 * math.exp(-0.3 * l)
        h = jnp.einsum('bsd,de->bse', x, w_in[l])
        a_q, a_k, a_v, b_q, b_k, b_v, c_u, c_v = jnp.split(h, IN_OFFSETS, axis=-1)

        a_q = apply_rope(a_q.reshape(bsz, s, A_HEADS, 2, A_QK_DIM), cos_a, sin_a)
        a_k = apply_rope(a_k.reshape(bsz, s, A_HEADS, 2, A_QK_DIM), cos_a, sin_a)
        a_v = a_v.reshape(bsz, s, A_HEADS, A_V_DIM)
        lq = lam_qk[l].astype(jnp.float32)
        lam = jnp.exp(jnp.sum(lq[0] * lq[1])) - jnp.exp(jnp.sum(lq[2] * lq[3])) + lam_init
        a_o = diff_attention(a_q, a_k, a_v, lam)
        a_o = (rms_norm(a_o, a_subln_g[l]) * (1.0 - lam_init)).reshape(bsz, s, A_WIDTH)

        b_q = rms_norm(b_q.reshape(bsz, s, B_KV_HEADS, B_GROUP, B_HEAD_DIM), b_q_norm_g[l])
        b_q = apply_axial_rope(b_q, cos_r, sin_r, cos_c, sin_c)
        b_k = rms_norm(b_k.reshape(bsz, s, B_KV_HEADS, B_HEAD_DIM), b_k_norm_g[l])
        b_k = apply_axial_rope(b_k, cos_r, sin_r, cos_c, sin_c)
        b_v = b_v.reshape(bsz, s, B_KV_HEADS, B_HEAD_DIM)
        b_o = gqa_attention(b_q, b_k, b_v).reshape(bsz, s, B_WIDTH)

        c_o = chunked_spatial_gating(jax.nn.gelu(c_u), jax.nn.gelu(c_v),
                                     c_w_s[l], c_b_s[l], c_ln_g[l], c_ln_b[l])

        mix = jnp.einsum('bse,ed->bsd', jnp.concatenate([a_o, b_o, c_o], axis=-1), w_out[l])
        x = layer_norm(DEEPNORM_ALPHA * x + mix, ln1_g[l], ln1_b[l])

        hid = jax.nn.silu(jnp.einsum('bsd,df->bsf', x, w_gate[l])) * jnp.einsum('bsd,df->bsf', x, w_up[l])
        ffn = jnp.einsum('bsf,fd->bsd', hid, w_down[l])
        x = layer_norm(DEEPNORM_ALPHA * x + ffn, ln2_g[l], ln2_b[l])
    return x
```

```cpp
#include <hip/hip_runtime.h>
#include <hip/hip_cooperative_groups.h>
#include <cstdio>
#include <cstdint>
namespace cg = cooperative_groups;
namespace pg8 {
#define PG8_LAS __attribute__((address_space(3)))
typedef unsigned short bf16_t;
typedef short bf16x8 __attribute__((ext_vector_type(8)));
typedef float f32x4 __attribute__((ext_vector_type(4)));
typedef unsigned u32x4 __attribute__((ext_vector_type(4)));
constexpr int BM = 256, BK = 64, HALF = 128, HTB = HALF * BK * 2  , STAGE_BYTES = 8 * HTB, NXCD = 8, WGM = 8;

__host__ __device__ __forceinline__ int lds_byte(int r, int c) { const int st = (r >> 4) * 2 + (c >> 5), rr = r & 15, cc = c & 31, ob = rr * 64 + cc * 2; return st * 1024 + (ob ^ (((ob >> 9) & 1) << 5)); }
__host__ __device__ __forceinline__ void stage_rc(int b, int& R, int& C) { const int st = b / 1024, sb = b % 1024, swz = sb ^ (((sb >> 9) & 1) << 5); R = (st >> 1) * 16 + swz / 64; C = (st & 1) * 32 + (swz % 64) / 2; }
__host__ __device__ __forceinline__ int perm32(int rho) { const int n = rho >> 4, i = rho & 15; return 8 * (i >> 2) + 4 * n + (i & 3); }

struct Unit { int pm, pn; };
struct Gemm { const bf16_t* A; const bf16_t* Bt; int M, N, K; };

struct StaticOrder {
    int nM, nN, nwg, G, c;
    __host__ __device__ void init(int M, int N, int G_, int c_) { nM = M / BM; nN = N / BM; nwg = nM * nN; G = G_; c = c_; }
    __host__ __device__ bool next(int i, Unit& u) const {
        const long L = (long)i * G + c; if (L >= nwg) return false;
        int wgid = (int)L; { const int q = nwg / NXCD, r = nwg % NXCD, xcd = wgid % NXCD, off = wgid / NXCD; wgid = (xcd < r ? xcd * (q + 1) : r * (q + 1) + (xcd - r) * q) + off; }
        const int nig = WGM * nN, gid = wgid / nig, fm = gid * WGM, gsz = (nM - fm) < WGM ? (nM - fm) : WGM;
        u.pm = fm + ((wgid % nig) % gsz); u.pn = (wgid % nig) / gsz; return true;
    }
    __device__ __forceinline__ void a_ready(const Unit&) const {}
    __device__ __forceinline__ void done(const Unit&) const {}
};

__device__ __forceinline__ unsigned cvt_pk_bf16(float lo, float hi) { unsigned r; asm volatile("v_cvt_pk_bf16_f32 %0, %1, %2" : "=v"(r) : "v"(lo), "v"(hi)); return r; }
typedef float f32x2 __attribute__((ext_vector_type(2)));
__device__ __forceinline__ f32x2 gelu_pk(f32x2 v) {
    const f32x2 av = __builtin_elementwise_abs(v), d = av * 0.2316418882f + 1.0f;
    f32x2 t; t.x = __builtin_amdgcn_rcpf(d.x); t.y = __builtin_amdgcn_rcpf(d.y);
    f32x2 q = t * 0.5307027145f + (-0.7265760135f); q = q * t + 0.7107068705f; q = q * t + (-0.142248368f); q = q * t + 0.127414796f; q = q * t;
    const f32x2 s = (v * v) * (-0.72134752044f);
    f32x2 e; e.x = __builtin_amdgcn_exp2f(s.x); e.y = __builtin_amdgcn_exp2f(s.y);
    const f32x2 m = v * (q * e), r = v - m;
    f32x2 o; o.x = v.x < 0.f ? m.x : r.x; o.y = v.y < 0.f ? m.y : r.y; return o;
}

template <int ACT  > struct EpiBf16 {
    static constexpr bool PERM = true, AFTER_DRAIN = false; static_assert(ACT == 0 || ACT == 1, "EpiBf16: ACT is 0 (none) or 1 (gelu_pk)");
    bf16_t* O; int ldc; const float* bias; int split_cols; size_t split_stride; float scale0;
    __device__ __forceinline__ void operator()(const f32x4 (&acc)[2][2][4][2], const Unit& u, int wr, int wc, int fr, int fq) const {
        const int row0 = u.pm * BM + wr * 64 + fr; int colt = u.pn * BM; bf16_t* base = O;
        float sc = 1.f; if (split_cols) { const int t = colt / split_cols; base += (size_t)t * split_stride; colt -= t * split_cols; if (t == 0) sc = scale0; }
        const int col0 = colt + wc * 32 + 8 * fq, bcol0 = u.pn * BM + wc * 32 + 8 * fq;
        f32x4 bv[2][2];
#pragma unroll
        for (int bj = 0; bj < 2; ++bj)
#pragma unroll
            for (int n = 0; n < 2; ++n) bv[bj][n] = bias ? *(const f32x4*)(bias + bcol0 + bj * HALF + 4 * n) : (f32x4){0.f, 0.f, 0.f, 0.f};
#pragma unroll
        for (int ai = 0; ai < 2; ++ai)
#pragma unroll
            for (int m = 0; m < 4; ++m) { bf16_t* rowp = base + (size_t)(row0 + ai * HALF + m * 16) * ldc + col0;
#pragma unroll
                for (int bj = 0; bj < 2; ++bj) { f32x4 v0 = acc[ai][bj][m][0] + bv[bj][0], v1 = acc[ai][bj][m][1] + bv[bj][1];
                    if (ACT == 1) { f32x2 a = gelu_pk((f32x2){v0[0], v0[1]}), b = gelu_pk((f32x2){v0[2], v0[3]}), c = gelu_pk((f32x2){v1[0], v1[1]}), d = gelu_pk((f32x2){v1[2], v1[3]});
                        v0 = (f32x4){a.x, a.y, b.x, b.y}; v1 = (f32x4){c.x, c.y, d.x, d.y}; }
                    v0 = v0 * sc; v1 = v1 * sc; u32x4 w; w.x = cvt_pk_bf16(v0[0], v0[1]); w.y = cvt_pk_bf16(v0[2], v0[3]); w.z = cvt_pk_bf16(v1[0], v1[1]); w.w = cvt_pk_bf16(v1[2], v1[3]);
                    *(u32x4*)(rowp + bj * HALF) = w; } }
    }
};
template <class Epi, class Sched, bool ALIGN_EPI = false, bool SP2 = false>
__device__ __forceinline__ void gemm_phase(PG8_LAS unsigned char* lds, const Gemm g, const Sched& S, const Epi& E) {
    int tid_ = threadIdx.x; asm volatile("" : "+v"(tid_));
    const int tid = tid_, wid = __builtin_amdgcn_readfirstlane(tid >> 6), lane = tid & 63, wr = wid >> 2, wc = wid & 3, fr = lane & 15, fq = lane >> 4;
    const int K = g.K, nt = K / BK;
    unsigned voffA[2], voffB[2];
#pragma unroll
    for (int i = 0; i < 2; ++i) { int R, C; stage_rc(tid * 16 + i * 8192, R, C); const int Rb = Epi::PERM ? ((R & ~31) + perm32(R & 31)) : R;
        voffA[i] = (unsigned)(R * K + C) * 2u; voffB[i] = (unsigned)(Rb * K + C) * 2u; }
    const size_t kstep = (size_t)(BK * 2);
    const size_t hstep = (size_t)HALF * K * 2;
    const size_t tstep = 2 * hstep;
    const unsigned ldsw = (unsigned)wid * 1024u;
    const int aoff = lds_byte(wr * 64 + fr, fq * 8), boff = lds_byte(wc * 32 + fr, fq * 8);
#define PG8_SA(b, h) (((b) * 2 + (h)) * HTB)
#define PG8_SB(b, h) ((4 + (b) * 2 + (h)) * HTB)
#define PG8_STAGE(bufoff, gbase, voff) do { _Pragma("unroll") for (int _i = 0; _i < 2; ++_i) \
        __builtin_amdgcn_global_load_lds((const unsigned*)((const char*)(gbase) + (voff)[_i]), (PG8_LAS unsigned*)(lds + (bufoff) + ldsw + _i * 8192), 16, 0, 0); } while (0)
#define PG8_LDA(dst, b, h) do { _Pragma("unroll") for (int m = 0; m < 4; ++m) _Pragma("unroll") for (int k = 0; k < 2; ++k) dst[m][k] = *(const PG8_LAS bf16x8*)(lds + PG8_SA(b, h) + aoff + m * 2048 + k * 1024); } while (0)
#define PG8_LDB(dst, b, h) do { _Pragma("unroll") for (int n = 0; n < 2; ++n) _Pragma("unroll") for (int k = 0; k < 2; ++k) dst[n][k] = *(const PG8_LAS bf16x8*)(lds + PG8_SB(b, h) + boff + n * 2048 + k * 1024); } while (0)
#define PG8_MMA(ai, bj, At, Bt) do { __builtin_amdgcn_s_setprio(1); _Pragma("unroll") for (int m = 0; m < 4; ++m) _Pragma("unroll") for (int n = 0; n < 2; ++n) _Pragma("unroll") for (int k = 0; k < 2; ++k) \
        acc[ai][bj][m][n] = __builtin_amdgcn_mfma_f32_16x16x32_bf16(Bt[n][k], At[m][k], acc[ai][bj][m][n], 0, 0, 0); __builtin_amdgcn_s_setprio(0); } while (0)
#define PG8_WAIT_V(n) asm volatile("s_waitcnt vmcnt(" #n ")" ::: "memory")
#define PG8_WAIT_L(n) asm volatile("s_waitcnt lgkmcnt(" #n ")" ::: "memory")
#define PG8_BAR __builtin_amdgcn_s_barrier()
#define PG8_SCHED __builtin_amdgcn_sched_barrier(0)
    Unit cur, nxt; int ui = 0;
    if (!S.next(0, cur)) return;
    f32x4 acc[2][2][4][2];
#pragma unroll
    for (int a = 0; a < 2; ++a)
#pragma unroll
        for (int b = 0; b < 2; ++b)
#pragma unroll
            for (int m = 0; m < 4; ++m)
#pragma unroll
                for (int n = 0; n < 2; ++n) acc[a][b][m][n] = (f32x4){0.f, 0.f, 0.f, 0.f};
    bf16x8 At[4][2], B0[2][2], B1[2][2];
    const char* cA = (const char*)g.A + (size_t)cur.pm * tstep; const char* cB = (const char*)g.Bt + (size_t)cur.pn * tstep;
    S.a_ready(cur);
    if constexpr (SP2) {
        PG8_STAGE(PG8_SB(0, 0), cB, voffB); PG8_STAGE(PG8_SB(0, 1), cB + hstep, voffB); PG8_STAGE(PG8_SA(0, 0), cA, voffA); PG8_STAGE(PG8_SA(0, 1), cA + hstep, voffA);
        if (wr == 1) PG8_BAR;
        PG8_WAIT_V(2); PG8_BAR;
        PG8_STAGE(PG8_SB(1, 0), cB + kstep, voffB); PG8_STAGE(PG8_SA(1, 0), cA + kstep, voffA); PG8_STAGE(PG8_SB(1, 1), cB + hstep + kstep, voffB);
        PG8_WAIT_V(6); PG8_BAR;
    } else {
        PG8_STAGE(PG8_SB(0, 0), cB, voffB); PG8_STAGE(PG8_SA(0, 0), cA, voffA); PG8_STAGE(PG8_SB(0, 1), cB + hstep, voffB); PG8_STAGE(PG8_SA(0, 1), cA + hstep, voffA);
        if (wr == 1) PG8_BAR;
        PG8_WAIT_V(4); PG8_BAR;
        PG8_STAGE(PG8_SB(1, 0), cB + kstep, voffB); PG8_STAGE(PG8_SA(1, 0), cA + kstep, voffA); PG8_STAGE(PG8_SB(1, 1), cB + hstep + kstep, voffB);
        PG8_WAIT_V(6); PG8_BAR;
    }
    for (;;) {
        const bool has_next = S.next(ui + 1, nxt);
        const char* nA = has_next ? (const char*)g.A + (size_t)nxt.pm * tstep : cA; const char* nB = has_next ? (const char*)g.Bt + (size_t)nxt.pn * tstep : cB;
        for (int t = 0; t < nt; t += 2) {
            const bool last = (t == nt - 2);
            const char* a1 = cA + (size_t)(t + 1) * kstep;
            const char* a2 = last ? nA : cA + (size_t)(t + 2) * kstep; const char* b2 = last ? nB : cB + (size_t)(t + 2) * kstep;
            const char* a3 = a2 + kstep; const char* b3 = b2 + kstep;
            if (last && has_next) S.a_ready(nxt);
            if constexpr (SP2) {
            PG8_LDB(B0, 0, 0); PG8_LDB(B1, 0, 1); PG8_SCHED; PG8_LDA(At, 0, 0); PG8_STAGE(PG8_SA(1, 1), a1 + hstep, voffA);
            PG8_WAIT_V(8); PG8_WAIT_L(0); PG8_BAR; PG8_MMA(0, 0, At, B0); PG8_MMA(0, 1, At, B1); PG8_BAR; PG8_SCHED;
            PG8_LDA(At, 0, 1); PG8_STAGE(PG8_SB(0, 0), b2, voffB); PG8_STAGE(PG8_SB(0, 1), b2 + hstep, voffB); PG8_STAGE(PG8_SA(0, 0), a2, voffA);
            PG8_WAIT_V(8); PG8_WAIT_L(0); PG8_BAR; PG8_MMA(1, 0, At, B0); PG8_MMA(1, 1, At, B1); PG8_BAR; PG8_SCHED;
            PG8_LDB(B0, 1, 0); PG8_LDB(B1, 1, 1); PG8_SCHED; PG8_LDA(At, 1, 0); PG8_STAGE(PG8_SA(0, 1), a2 + hstep, voffA);
            PG8_WAIT_V(8); PG8_WAIT_L(0); PG8_BAR; PG8_MMA(0, 0, At, B0); PG8_MMA(0, 1, At, B1); PG8_BAR; PG8_SCHED;
            PG8_LDA(At, 1, 1); PG8_STAGE(PG8_SB(1, 0), b3, voffB); PG8_STAGE(PG8_SB(1, 1), b3 + hstep, voffB); PG8_STAGE(PG8_SA(1, 0), a3, voffA);
            PG8_WAIT_V(8); PG8_WAIT_L(0); PG8_BAR; PG8_MMA(1, 0, At, B0); PG8_MMA(1, 1, At, B1); PG8_BAR; PG8_SCHED;
            } else {
            PG8_LDB(B0, 0, 0); PG8_SCHED; PG8_LDA(At, 0, 0); PG8_STAGE(PG8_SA(1, 1), a1 + hstep, voffA);
            PG8_WAIT_L(8); PG8_BAR; PG8_WAIT_L(0); PG8_MMA(0, 0, At, B0); PG8_BAR; PG8_SCHED;
            PG8_LDB(B1, 0, 1); PG8_STAGE(PG8_SB(0, 0), b2, voffB);
            PG8_BAR; PG8_WAIT_L(0); PG8_MMA(0, 1, At, B1); PG8_BAR;
            PG8_LDA(At, 0, 1); PG8_STAGE(PG8_SA(0, 0), a2, voffA);
            PG8_BAR; PG8_WAIT_L(0); PG8_MMA(1, 0, At, B0); PG8_BAR; PG8_SCHED;
            PG8_STAGE(PG8_SB(0, 1), b2 + hstep, voffB);
            PG8_WAIT_V(6); PG8_BAR; PG8_MMA(1, 1, At, B1); PG8_BAR;
            PG8_LDB(B0, 1, 0); PG8_SCHED; PG8_LDA(At, 1, 0); PG8_STAGE(PG8_SA(0, 1), a2 + hstep, voffA);
            PG8_WAIT_L(8); PG8_BAR; PG8_WAIT_L(0); PG8_MMA(0, 0, At, B0); PG8_BAR; PG8_SCHED;
            PG8_LDB(B1, 1, 1); PG8_STAGE(PG8_SB(1, 0), b3, voffB);
            PG8_BAR; PG8_WAIT_L(0); PG8_MMA(0, 1, At, B1); PG8_BAR;
            PG8_LDA(At, 1, 1); PG8_STAGE(PG8_SA(1, 0), a3, voffA);
            PG8_BAR; PG8_WAIT_L(0); PG8_MMA(1, 0, At, B0); PG8_BAR; PG8_SCHED;
            PG8_STAGE(PG8_SB(1, 1), b3 + hstep, voffB);
            PG8_WAIT_V(6); PG8_BAR; PG8_MMA(1, 1, At, B1); PG8_BAR;
            }
        }
        if constexpr (ALIGN_EPI) { if (wr == 0) PG8_BAR; }
        if constexpr (!Epi::AFTER_DRAIN) { E(acc, cur, wr, wc, fr, fq); S.done(cur); }
        if (!has_next) break;
#pragma unroll
        for (int a = 0; a < 2; ++a)
#pragma unroll
            for (int b = 0; b < 2; ++b)
#pragma unroll
                for (int m = 0; m < 4; ++m)
#pragma unroll
                    for (int n = 0; n < 2; ++n) acc[a][b][m][n] = (f32x4){0.f, 0.f, 0.f, 0.f};
        cur = nxt; cA = nA; cB = nB; ++ui;
        if constexpr (ALIGN_EPI) { if (wr == 1) PG8_BAR; }
    }
    PG8_WAIT_V(0);
    if constexpr (!ALIGN_EPI) { if (wr == 0) PG8_BAR; }
    PG8_BAR;
    if constexpr (Epi::AFTER_DRAIN) { E.fused(acc, cur, wr, wc, fr, fq, lds, wid, lane); S.done(cur); }
#undef PG8_SA
#undef PG8_SB
#undef PG8_STAGE
#undef PG8_LDA
#undef PG8_LDB
#undef PG8_MMA
#undef PG8_WAIT_V
#undef PG8_WAIT_L
#undef PG8_BAR
#undef PG8_SCHED
}
}

constexpr int BATCH = 32, SEQ = 2048, DM = 1024, DEPTH = 4, MROWS = BATCH * SEQ;
constexpr int INC = 2048, FFH = 2816, GU = 2 * FFH;
constexpr float LN_EPS = 1e-5f;
constexpr float ALPHA = 1.6817928305074290f;
constexpr float LOG2E = 1.4426950408889634f;
constexpr float SCALE_A = 0.17677669529663687f * LOG2E;
constexpr float SCALE_B = 0.125f * LOG2E;
constexpr int NT = 512;

#define LAS __attribute__((address_space(3)))
typedef unsigned short bf16;
typedef short bf16x8 __attribute__((ext_vector_type(8)));
typedef float f32x4 __attribute__((ext_vector_type(4)));
typedef float f32x16 __attribute__((ext_vector_type(16)));
typedef unsigned u32x4 __attribute__((ext_vector_type(4)));
typedef unsigned u32x2 __attribute__((ext_vector_type(2)));
typedef float f32x2 __attribute__((ext_vector_type(2)));

constexpr size_t MiB = 1u << 20;
constexpr size_t WS_TAB = 1 * MiB;
constexpr size_t WS_STATS = 3 * MiB;
constexpr size_t WS_WSB = 2 * MiB;
constexpr size_t WS_W = 4 * MiB, W_LAYER = 23 * MiB, W_IN = 0, W_O = 4 * MiB, W_GU = 6 * MiB, W_D = 17 * MiB;
constexpr size_t WS_XB = 96 * MiB;
constexpr size_t WS_H = 224 * MiB;
constexpr size_t WS_CAT = 480 * MiB;
constexpr size_t WS_HID = 608 * MiB;
constexpr size_t WS_END = 960 * MiB;
constexpr int LDS_BYTES = 147456;
constexpr int MISC_OFF = 147456 - 64;
constexpr size_t WS_BAR = 0;
#define XB_TMO      128
#define XB_XCNT(j)  (256  + 64 * (j))
#define XB_XSUB(j)  (1280 + 64 * (j))
#define XB_XGEN(j)  (2304 + 64 * (j))
#define XB_TOP      3328
#define XB_TOPGEN   3392
#define XCD_BAR_WORDS 3456
#define XB_SPIN_CAP (1u << 22)

__device__ __forceinline__ unsigned xb_ld(unsigned* p)              { return __hip_atomic_load(p, __ATOMIC_RELAXED, __HIP_MEMORY_SCOPE_AGENT); }
__device__ __forceinline__ unsigned xb_add(unsigned* p, unsigned v) { return __hip_atomic_fetch_add(p, v, __ATOMIC_RELAXED, __HIP_MEMORY_SCOPE_AGENT); }
__device__ __forceinline__ unsigned xb_xcc_id() { return (unsigned)__builtin_amdgcn_s_getreg((3 << 11) | 20) & 0xFu; }
#define XB_SPIN(cond, bar) do { unsigned _sp = 0; while (cond) { __builtin_amdgcn_s_sleep(1); \
    if ((++_sp & 255u) == 0u) { if (xb_ld(&(bar)[XB_TMO])) break; if (_sp > XB_SPIN_CAP) { atomicAdd(&(bar)[XB_TMO], 1u); break; } } } } while (0)

struct XcdBarrier {
    unsigned* bar; unsigned x;
    volatile LAS unsigned* st;
};

__device__ __forceinline__ XcdBarrier xcd_barrier_post(unsigned* bar, volatile LAS unsigned* st) {
    XcdBarrier b; b.bar = bar; b.x = xb_xcc_id(); b.st = st;
    if (threadIdx.x == 0) (void)xb_add(&bar[XB_XCNT(b.x)], 1u);
    return b;
}
__device__ __forceinline__ void xcd_barrier_complete(unsigned* bar, unsigned x, unsigned& nloc, unsigned& nx) {
    const unsigned G = gridDim.x * gridDim.y * gridDim.z;
    unsigned sum, cnt, mine, sp = 0u;
    for (;;) {
        sum = 0u; cnt = 0u; mine = 0u;
#pragma unroll
        for (unsigned j = 0; j < 16; ++j) { const unsigned c = xb_ld(&bar[XB_XCNT(j)]); sum += c; cnt += (c > 0u) ? 1u : 0u; mine = (j == x) ? c : mine; }
        if (sum == G) break;
        __builtin_amdgcn_s_sleep(1);
        if ((++sp & 255u) == 0u) { if (xb_ld(&bar[XB_TMO])) break; if (sp > XB_SPIN_CAP) { atomicAdd(&bar[XB_TMO], 1u); break; } }
    }
    nloc = mine > 0u ? mine : 1u; nx = cnt > 0u ? cnt : 1u;
}

__device__ __forceinline__ void xcd_barrier(const XcdBarrier& b) {
    asm volatile("s_waitcnt vmcnt(0)" ::: "memory");
    __syncthreads();
    if (threadIdx.x == 0) {
        unsigned* bar = b.bar;
        __builtin_amdgcn_s_waitcnt(0);
        unsigned nloc = b.st[0], nx = b.st[1];
        if (nloc == 0u) { xcd_barrier_complete(bar, b.x, nloc, nx); b.st[0] = nloc; b.st[1] = nx; }
        const unsigned old = xb_add(&bar[XB_XSUB(b.x)], 1u);
        const unsigned gen = old / nloc;
        if (old + 1u == (gen + 1u) * nloc) {
            __builtin_amdgcn_fence(__ATOMIC_RELEASE, "agent");
            asm volatile("s_waitcnt vmcnt(0)" ::: "memory");
            const unsigned og = xb_add(&bar[XB_TOP], 1u);
            const unsigned tg = og / nx;
            if (og + 1u == (tg + 1u) * nx) xb_add(&bar[XB_TOPGEN], 1u);
            else XB_SPIN(xb_ld(&bar[XB_TOPGEN]) == tg, bar);
            __builtin_amdgcn_fence(__ATOMIC_ACQUIRE, "agent");
            xb_add(&bar[XB_XGEN(b.x)], 1u);
            asm volatile("s_waitcnt vmcnt(0)" ::: "memory");
        } else {
            XB_SPIN(xb_ld(&bar[XB_XGEN(b.x)]) == gen, bar);
            __builtin_amdgcn_fence(__ATOMIC_ACQUIRE, "agent");
            asm volatile("s_waitcnt vmcnt(0)" ::: "memory");
        }
    }
    __syncthreads();
}

__device__ __forceinline__ unsigned f2bf(float f) { unsigned u = __builtin_bit_cast(unsigned, f); return (u + 0x7fffu + ((u >> 16) & 1u)) >> 16; }
__device__ __forceinline__ unsigned pk2(float lo, float hi) { return pg8::cvt_pk_bf16(lo, hi); }
__device__ __forceinline__ float bflo(unsigned u) { return __uint_as_float(u << 16); }
__device__ __forceinline__ float bfhi(unsigned u) { return __uint_as_float(u & 0xffff0000u); }
__device__ __forceinline__ float ex2(float x) { return __builtin_amdgcn_exp2f(x); }
__device__ __forceinline__ float gelu_tanh(float x) {
    const float z = 0.7978845608028654f * (x + 0.044715f * x * x * x);
    return x * __builtin_amdgcn_rcpf(1.f + ex2(-2.f * LOG2E * z));
}

struct EpiRes {
    static constexpr bool PERM = true, AFTER_DRAIN = false;
    const float* res; float* out; const f32x2* stats; const float* g; const float* bta;
    __device__ __forceinline__ void operator()(const pg8::f32x4 (&acc)[2][2][4][2], const pg8::Unit& u, int wr, int wc, int fr, int fq) const {
        const int row0 = u.pm * 256 + wr * 64 + fr, col0 = u.pn * 256 + wc * 32 + 8 * fq;
#pragma unroll
        for (int bj = 0; bj < 2; ++bj) {
            f32x4 g0 = {ALPHA, ALPHA, ALPHA, ALPHA}, g1 = g0, b0 = {0.f, 0.f, 0.f, 0.f}, b1 = b0;
            if (stats) { g0 = *(const f32x4*)(g + col0 + bj * 128) * ALPHA; g1 = *(const f32x4*)(g + col0 + bj * 128 + 4) * ALPHA; b0 = *(const f32x4*)(bta + col0 + bj * 128) * ALPHA; b1 = *(const f32x4*)(bta + col0 + bj * 128 + 4) * ALPHA; }
#pragma unroll
            for (int ai = 0; ai < 2; ++ai)
#pragma unroll
                for (int m = 0; m < 4; ++m) { const int row = row0 + ai * 128 + m * 16; const size_t off = (size_t)row * DM + col0 + bj * 128;
                    f32x4 r0 = *(const f32x4*)(res + off), r1 = *(const f32x4*)(res + off + 4);
                    if (stats) { const f32x2 st = stats[row]; r0 = (r0 - st.x) * st.y; r1 = (r1 - st.x) * st.y; }
                    *(f32x4*)(out + off) = r0 * g0 + b0 + acc[ai][bj][m][0]; *(f32x4*)(out + off + 4) = r1 * g1 + b1 + acc[ai][bj][m][1]; }
        }
    }
};
struct EpiInProj {
    static constexpr bool PERM = true, AFTER_DRAIN = false;
    bf16* O; const f32x2* tab;
    __device__ __forceinline__ void operator()(const pg8::f32x4 (&acc)[2][2][4][2], const pg8::Unit& u, int wr, int wc, int fr, int fq) const {
        const int row0 = u.pm * 256 + wr * 64 + fr, col0 = u.pn * 256 + wc * 32 + 8 * fq;
        const int mode = u.pn <= 1 ? 1 : (u.pn >= 6 ? 2 : 0);
        const float sc = u.pn == 0 ? SCALE_A : 1.f;
        const bool lowh = fq < 2; const int i0 = 8 * (fq & 1);
#pragma unroll
        for (int ai = 0; ai < 2; ++ai)
#pragma unroll
            for (int m = 0; m < 4; ++m) { const int row = row0 + ai * 128 + m * 16; bf16* rowp = O + (size_t)row * INC + col0;
                f32x4 cs[4] = {};
                if (mode == 1) { const f32x4* tp = (const f32x4*)(tab + (row & (SEQ - 1)) * 16 + i0);
#pragma unroll
                    for (int k = 0; k < 4; ++k) cs[k] = tp[k]; }
#pragma unroll
                for (int bj = 0; bj < 2; ++bj) { float v[8];
#pragma unroll
                    for (int n = 0; n < 2; ++n)
#pragma unroll
                        for (int j = 0; j < 4; ++j) v[4 * n + j] = acc[ai][bj][m][n][j];
                    if (mode == 2) {
#pragma unroll
                        for (int j = 0; j < 8; ++j) v[j] = gelu_tanh(v[j]);
                    } else if (mode == 1) {
#pragma unroll
                        for (int j = 0; j < 8; ++j) { auto rr = __builtin_amdgcn_permlane32_swap(__float_as_uint(v[j]), __float_as_uint(v[j]), false, false);
                            const float pr = __uint_as_float(lowh ? rr[1] : rr[0]);
                            const float c = cs[j >> 1][2 * (j & 1)], s = cs[j >> 1][2 * (j & 1) + 1];
                            v[j] = (lowh ? v[j] * c - pr * s : v[j] * c + pr * s) * sc; }
                    }
                    u32x4 w; w.x = pk2(v[0], v[1]); w.y = pk2(v[2], v[3]); w.z = pk2(v[4], v[5]); w.w = pk2(v[6], v[7]);
                    *(u32x4*)(rowp + bj * 128) = w; } }
    }
};
struct EpiSwiglu {
    static constexpr bool PERM = true, AFTER_DRAIN = false;
    bf16* O;
    __device__ __forceinline__ void operator()(const pg8::f32x4 (&acc)[2][2][4][2], const pg8::Unit& u, int wr, int wc, int fr, int fq) const {
        const int row0 = u.pm * 256 + wr * 64 + fr, col0 = u.pn * 128 + wc * 32 + 8 * fq;
#pragma unroll
        for (int ai = 0; ai < 2; ++ai)
#pragma unroll
            for (int m = 0; m < 4; ++m) { float v[8];
#pragma unroll
                for (int n = 0; n < 2; ++n)
#pragma unroll
                    for (int j = 0; j < 4; ++j) { const float g = acc[ai][0][m][n][j], up = acc[ai][1][m][n][j]; v[4 * n + j] = g * __builtin_amdgcn_rcpf(1.f + ex2(-LOG2E * g)) * up; }
                u32x4 w; w.x = pk2(v[0], v[1]); w.y = pk2(v[2], v[3]); w.z = pk2(v[4], v[5]); w.w = pk2(v[6], v[7]);
                *(u32x4*)(O + (size_t)(row0 + ai * 128 + m * 16) * FFH + col0) = w; }
    }
};

__device__ __forceinline__ void transpose_item(const float* __restrict__ W, int K, int N, bf16* __restrict__ WT, int k0, int n0, int drow0, LAS float* scr, int lane) {
#pragma unroll 16
    for (int i = 0; i < 32; ++i) { const int kk = 2 * i + (lane >> 5); scr[kk * 33 + (lane & 31)] = W[(size_t)(k0 + kk) * N + n0 + (lane & 31)]; }
    asm volatile("s_waitcnt lgkmcnt(0)" ::: "memory");
    const int c = lane & 7;
#pragma unroll
    for (int j = 0; j < 4; ++j) { const int n = (lane >> 3) + 8 * j; const LAS float* s = scr + (8 * c) * 33 + n;
        u32x4 o; o.x = pk2(s[0 * 33], s[1 * 33]); o.y = pk2(s[2 * 33], s[3 * 33]); o.z = pk2(s[4 * 33], s[5 * 33]); o.w = pk2(s[6 * 33], s[7 * 33]);
        *(u32x4*)(WT + (size_t)(drow0 + n) * K + k0 + 8 * c) = o; }
    asm volatile("s_waitcnt lgkmcnt(0)" ::: "memory");
}

struct Args { const float* in[18]; float* out; unsigned char* ws; };
struct Ctx {
    const float* const* in; float* out; unsigned char* ws;
    int tid, lane, wave, vcu, G;
};

__device__ __forceinline__ void p0_prologue(const Ctx& F, LAS unsigned char* lds) {
    LAS float* scr = (LAS float*)(lds + F.wave * 16384);
    const int gw = F.vcu * 8 + F.wave, NGW = F.G * 8;
    constexpr int PER_LAYER = 1024 + 512 + 1408 + 1408 + 1408;
    for (int it = gw; it < DEPTH * PER_LAYER; it += NGW) {
        const int l = it / PER_LAYER; int r = it % PER_LAYER;
        unsigned char* wl = F.ws + WS_W + (size_t)l * W_LAYER;
        if (r < 1024) { const int kb = r / 64, nb = r % 64; transpose_item(F.in[1] + (size_t)l * DM * INC, DM, INC, (bf16*)(wl + W_IN), 64 * kb, 32 * nb, 32 * nb, scr, F.lane); continue; }
        r -= 1024;
        if (r < 512) { const int kb = r / 32, nb = r % 32; transpose_item(F.in[2] + (size_t)l * DM * DM, DM, DM, (bf16*)(wl + W_O), 64 * kb, 32 * nb, 32 * nb, scr, F.lane); continue; }
        r -= 512;
        if (r < 1408) { const int kb = r / 88, nb = r % 88, n0 = 32 * nb; transpose_item(F.in[13] + (size_t)l * DM * FFH, DM, FFH, (bf16*)(wl + W_GU), 64 * kb, n0, 256 * (n0 / 128) + (n0 % 128), scr, F.lane); continue; }
        r -= 1408;
        if (r < 1408) { const int kb = r / 88, nb = r % 88, n0 = 32 * nb; transpose_item(F.in[14] + (size_t)l * DM * FFH, DM, FFH, (bf16*)(wl + W_GU), 64 * kb, n0, 256 * (n0 / 128) + 128 + (n0 % 128), scr, F.lane); continue; }
        r -= 1408;
        { const int kb = r / 32, nb = r % 32; transpose_item(F.in[15] + (size_t)l * FFH * DM, FFH, DM, (bf16*)(wl + W_D), 64 * kb, 32 * nb, 32 * nb, scr, F.lane); }
    }
    const float* x = F.in[0]; bf16* xb = (bf16*)(F.ws + WS_XB);
    for (int m0 = gw * 4; m0 < MROWS; m0 += NGW * 4) {
        f32x4 v[4][4];
#pragma unroll
        for (int i = 0; i < 4; ++i) { const f32x4* xr = (const f32x4*)(x + (size_t)(m0 + i) * DM) + F.lane;
#pragma unroll
            for (int j = 0; j < 4; ++j) v[i][j] = xr[64 * j]; }
#pragma unroll
        for (int i = 0; i < 4; ++i) { u32x2* o8 = (u32x2*)(xb + (size_t)(m0 + i) * DM) + F.lane;
#pragma unroll
            for (int j = 0; j < 4; ++j) { u32x2 w; w.x = pk2(v[i][j].x, v[i][j].y); w.y = pk2(v[i][j].z, v[i][j].w); o8[64 * j] = w; } }
    }
    const int gt = F.vcu * NT + F.tid, NGT = F.G * NT;
    f32x2* tab = (f32x2*)(F.ws + WS_TAB);
    for (int e = gt; e < 2048 * 16; e += NGT) { const int pos = e >> 4, i = e & 15;
        const float inv = 1.0f / powf(10000.0f, (float)i * (1.0f / 16.0f)); const float ang = (float)pos * inv;
        tab[e] = (f32x2){cosf(ang), sinf(ang)}; }
    bf16* wsb = (bf16*)(F.ws + WS_WSB); const float* cws = F.in[9];
    for (int e = gt; e < DEPTH * 4 * 128 * 128; e += NGT) wsb[e] = (bf16)f2bf(cws[e]);
}

__device__ __forceinline__ void p1b_postproc(const Ctx& F, int l) {
    int lane_ = F.lane; asm volatile("" : "+v"(lane_));
    const int gw = F.vcu * 8 + F.wave, NGW = F.G * 8, sidx = lane_ & 31, rsel = lane_ >> 5;
    bf16* h = (bf16*)(F.ws + WS_H);
    const f32x2* tab = (const f32x2*)(F.ws + WS_TAB);
    const float* bqg = F.in[5] + l * 64; const float* bkg = F.in[6] + l * 64; const float* clg = F.in[7] + l * 256; const float* clb = F.in[8] + l * 256;
    const bool isB = sidx < 20, isCv = sidx >= 24, act = isB || isCv;
    const int seg = isB ? 24 + sidx : 32 + sidx;
    const int half = sidx & 1;
    const float* gsrc = (sidx < 16 ? bqg : bkg) + 32 * half;
    const float scale = sidx < 16 ? SCALE_B : 1.f;
    const int c0 = 32 * (sidx & 7);
    for (int m0 = gw * 8; m0 < MROWS; m0 += NGW * 8) {
      u32x4 rawv[4][4];
#pragma unroll
      for (int i = 0; i < 4; ++i) { const u32x4* p_ = (const u32x4*)(h + (size_t)(m0 + 2 * i + rsel) * INC + 32 * seg);
          if (act) {
#pragma unroll
              for (int k = 0; k < 4; ++k) rawv[i][k] = p_[k];
          } else {
#pragma unroll
              for (int k = 0; k < 4; ++k) rawv[i][k] = (u32x4){0u, 0u, 0u, 0u};
          } }
#pragma unroll
      for (int i4 = 0; i4 < 4; ++i4) {
        const int m = m0 + 2 * i4 + rsel;
        const int t = m & (SEQ - 1);
        u32x4* p = (u32x4*)(h + (size_t)m * INC + 32 * seg);
        float v[32];
#pragma unroll
        for (int k = 0; k < 4; ++k) { const u32x4 raw = rawv[i4][k];
            v[8 * k + 0] = bflo(raw.x); v[8 * k + 1] = bfhi(raw.x); v[8 * k + 2] = bflo(raw.y); v[8 * k + 3] = bfhi(raw.y);
            v[8 * k + 4] = bflo(raw.z); v[8 * k + 5] = bfhi(raw.z); v[8 * k + 6] = bflo(raw.w); v[8 * k + 7] = bfhi(raw.w); }
        float s = 0.f, ss = 0.f;
#pragma unroll
        for (int i = 0; i < 32; ++i) { s += v[i]; ss += v[i] * v[i]; }
        const float ss2 = ss + __shfl_xor(ss, 1);
        float s8 = s; s8 += __shfl_xor(s8, 1); s8 += __shfl_xor(s8, 2); s8 += __shfl_xor(s8, 4);
        const float mu = s8 * (1.f / 256.f);
        float dq = 0.f;
#pragma unroll
        for (int i = 0; i < 32; ++i) { const float d = v[i] - mu; dq += d * d; }
        dq += __shfl_xor(dq, 1); dq += __shfl_xor(dq, 2); dq += __shfl_xor(dq, 4);
        const float rstd = 1.f / sqrtf(dq * (1.f / 256.f) + LN_EPS);
        if (isCv) {
#pragma unroll
            for (int i = 0; i < 32; ++i) v[i] = (v[i] - mu) * rstd * clg[c0 + i] + clb[c0 + i];
        } else if (isB) {
            const float rs = 1.f / sqrtf(ss2 * (1.f / 64.f) + LN_EPS);
#pragma unroll
            for (int i = 0; i < 32; ++i) v[i] = v[i] * rs * gsrc[i];
            const int pos = half ? (t & 63) : (t >> 6);
            const f32x2* tp = tab + pos * 16;
#pragma unroll
            for (int i = 0; i < 16; ++i) { const f32x2 cs = tp[i]; const float x1 = v[i], x2 = v[i + 16];
                v[i] = (x1 * cs.x - x2 * cs.y) * scale; v[i + 16] = (x2 * cs.x + x1 * cs.y) * scale; }
        }
        if (act) {
#pragma unroll
            for (int k = 0; k < 4; ++k) { u32x4 w; w.x = pk2(v[8 * k + 0], v[8 * k + 1]); w.y = pk2(v[8 * k + 2], v[8 * k + 3]); w.z = pk2(v[8 * k + 4], v[8 * k + 5]); w.w = pk2(v[8 * k + 6], v[8 * k + 7]); p[k] = w; }
        }
      }
    }
}

template <bool FINAL>
__device__ __forceinline__ void ln_pass(const Ctx& F, const float* __restrict__ g, const float* __restrict__ bta) {
    int lane_ = F.lane; asm volatile("" : "+v"(lane_));
    const int gw = F.vcu * 8 + F.wave, NGW = F.G * 8;
    float* X = F.out; bf16* xb = (bf16*)(F.ws + WS_XB); f32x2* stats = (f32x2*)(F.ws + WS_STATS);
    f32x4 gv[4], bv[4];
#pragma unroll
    for (int j = 0; j < 4; ++j) { gv[j] = ((const f32x4*)g)[lane_ + 64 * j]; bv[j] = ((const f32x4*)bta)[lane_ + 64 * j]; }
    for (int m0 = gw * 4; m0 < MROWS; m0 += NGW * 4) {
        f32x4 v[4][4];
#pragma unroll
        for (int i = 0; i < 4; ++i) { const f32x4* xr = (const f32x4*)(X + (size_t)(m0 + i) * DM) + lane_;
#pragma unroll
            for (int j = 0; j < 4; ++j) v[i][j] = xr[64 * j]; }
#pragma unroll
        for (int i = 0; i < 4; ++i) {
            float s = 0.f;
#pragma unroll
            for (int j = 0; j < 4; ++j) s += (v[i][j].x + v[i][j].y) + (v[i][j].z + v[i][j].w);
#pragma unroll
            for (int o = 1; o < 64; o <<= 1) s += __shfl_xor(s, o);
            const float mean = s * (1.f / DM); float s2 = 0.f;
#pragma unroll
            for (int j = 0; j < 4; ++j) { v[i][j] = v[i][j] - mean; s2 += (v[i][j].x * v[i][j].x + v[i][j].y * v[i][j].y) + (v[i][j].z * v[i][j].z + v[i][j].w * v[i][j].w); }
#pragma unroll
            for (int o = 1; o < 64; o <<= 1) s2 += __shfl_xor(s2, o);
            const float rstd = 1.f / sqrtf(s2 * (1.f / DM) + LN_EPS);
            if constexpr (FINAL) { f32x4* xr = (f32x4*)(X + (size_t)(m0 + i) * DM) + lane_;
#pragma unroll
                for (int j = 0; j < 4; ++j) xr[64 * j] = v[i][j] * rstd * gv[j] + bv[j];
            } else { u32x2* o8 = (u32x2*)(xb + (size_t)(m0 + i) * DM) + lane_;
#pragma unroll
                for (int j = 0; j < 4; ++j) { const f32x4 y = v[i][j] * rstd * gv[j] + bv[j]; u32x2 w; w.x = pk2(y.x, y.y); w.y = pk2(y.z, y.w); o8[64 * j] = w; }
                if (lane_ == 0) stats[m0 + i] = (f32x2){mean, rstd}; }
        }
    }
}

constexpr int KP = 144, VP = 272;
constexpr int VG = 8 * VP + 16;
constexpr int KT_BYTES = 128 * KP, VT_BYTES = 8 * VG, STG_BYTES = KT_BYTES + VT_BYTES;
constexpr int LDS_COMB = 2 * STG_BYTES;
constexpr float RESC_THR = 8.f;
__device__ __forceinline__ float max3f(float a, float b, float c) { return fmaxf(fmaxf(a, b), c); }
__device__ __forceinline__ float xh_max(float v) { auto rr = __builtin_amdgcn_permlane32_swap(__float_as_uint(v), __float_as_uint(v), false, false); return fmaxf(__uint_as_float(rr[0]), __uint_as_float(rr[1])); }
__device__ __forceinline__ float xh_sum(float v) { auto rr = __builtin_amdgcn_permlane32_swap(__float_as_uint(v), __float_as_uint(v), false, false); return __uint_as_float(rr[0]) + __uint_as_float(rr[1]); }
template <bool DIFF>
__device__ __forceinline__ void attn_unit(LAS unsigned char* lds, const bf16* __restrict__ h, bf16* __restrict__ cat,
                                          int b, int row0, int qoff, int koff, int voff, int ooff, float lam, float oscale, const float* __restrict__ subg) {
    constexpr int NQK = DIFF ? 2 : 4;
    int tid_ = threadIdx.x; asm volatile("" : "+v"(tid_));
    const int tid = tid_, lane = tid & 63, wid = __builtin_amdgcn_readfirstlane(tid >> 6), r32 = lane & 31, hi = lane >> 5;
    const int wq = DIFF ? (wid & 3) : wid, comp = DIFF ? (wid >> 2) : 0;
    const size_t rowbase = (size_t)b * SEQ;
    const size_t qrow = rowbase + row0 + wq * 64 + r32;
    bf16x8 qf[2][NQK];
#pragma unroll
    for (int qb = 0; qb < 2; ++qb)
#pragma unroll
        for (int d0 = 0; d0 < NQK; ++d0) qf[qb][d0] = *(const bf16x8*)(h + (qrow + 32 * qb) * INC + qoff + 32 * comp + 16 * d0 + 8 * hi);
    const int srow = tid >> 3, sch = tid & 7;
    const bf16* kp = h + (rowbase + srow) * INC + koff + sch * 8;
    const bf16* vp = h + (rowbase + srow) * INC + voff + sch * 8;
    const int kwoff = srow * KP + sch * 16;
    const int vwoff = KT_BYTES + sch * VG + srow * 2;
    const int kroff = r32 * KP + hi * 16 + comp * 64;
    const int vroff = KT_BYTES + (r32 >> 3) * VG + (r32 & 7) * VP + hi * 8;
    u32x4 kr0, kr1, vr0, vr1;
#define ATT_LOAD(t) do { kr0 = *(const u32x4*)(kp + (size_t)(t) * 128 * INC); kr1 = *(const u32x4*)(kp + ((size_t)(t) * 128 + 64) * INC); \
                         vr0 = *(const u32x4*)(vp + (size_t)(t) * 128 * INC); vr1 = *(const u32x4*)(vp + ((size_t)(t) * 128 + 64) * INC); } while (0)
#define ATT_STAGE(buf) do { LAS unsigned char* sb_ = lds + (buf) * STG_BYTES; *(LAS u32x4*)(sb_ + kwoff) = kr0; *(LAS u32x4*)(sb_ + kwoff + 64 * KP) = kr1; \
        _Pragma("unroll") for (int i_ = 0; i_ < 8; ++i_) { *(LAS unsigned short*)(sb_ + vwoff + i_ * VP) = (unsigned short)(vr0[i_ >> 1] >> (16 * (i_ & 1))); \
                                                          *(LAS unsigned short*)(sb_ + vwoff + i_ * VP + 128) = (unsigned short)(vr1[i_ >> 1] >> (16 * (i_ & 1))); } } while (0)
    ATT_LOAD(0);
    ATT_STAGE(0);
    __syncthreads();
    f32x16 o[2][2]; float mref[2], lsum[2];
#pragma unroll
    for (int qb = 0; qb < 2; ++qb) { mref[qb] = -1e30f; lsum[qb] = 0.f;
#pragma unroll
        for (int db = 0; db < 2; ++db)
#pragma unroll
            for (int r = 0; r < 16; ++r) o[qb][db][r] = 0.f; }
    __builtin_amdgcn_s_waitcnt(0x0F70);
    for (int t = 0; t < SEQ / 128; ++t) {
        const int buf = t & 1;
        if (t + 1 < SEQ / 128) ATT_LOAD(t + 1);
        const LAS unsigned char* sbase = lds + buf * STG_BYTES;
        bf16x8 kfr[2][NQK], vfr[2][2];
#define LOAD_K(SET, BLK4) do { const LAS unsigned char* kb_ = sbase + kroff + (BLK4) * 32 * KP; \
            _Pragma("unroll") for (int d0 = 0; d0 < NQK; ++d0) kfr[SET][d0] = *(const LAS bf16x8*)(kb_ + d0 * 32); } while (0)
#define LOAD_V(BLK4) do { const LAS unsigned char* vb_ = sbase + vroff + (BLK4) * 64; \
            _Pragma("unroll") for (int db = 0; db < 2; ++db) _Pragma("unroll") for (int ss = 0; ss < 2; ++ss) { const LAS unsigned char* a_ = vb_ + db * 4 * VG + ss * 32; \
                const u32x2 lo_ = *(const LAS u32x2*)a_, hh_ = *(const LAS u32x2*)(a_ + 16); vfr[db][ss] = __builtin_bit_cast(bf16x8, (u32x4){lo_.x, lo_.y, hh_.x, hh_.y}); } } while (0)
        LOAD_K(0, 0);
#pragma unroll
        for (int b4 = 0; b4 < 4; ++b4) {
            const int cur = b4 & 1;
            LOAD_V(b4);
            if (b4 < 3) { if (cur == 0) LOAD_K(1, b4 + 1); else LOAD_K(0, b4 + 1); }
            f32x16 s[2];
#pragma unroll
            for (int qb = 0; qb < 2; ++qb)
#pragma unroll
                for (int r = 0; r < 16; ++r) s[qb][r] = 0.f;
#pragma unroll
            for (int d0 = 0; d0 < NQK; ++d0) {
                s[0] = __builtin_amdgcn_mfma_f32_32x32x16_bf16(kfr[cur][d0], qf[0][d0], s[0], 0, 0, 0);
                s[1] = __builtin_amdgcn_mfma_f32_32x32x16_bf16(kfr[cur][d0], qf[1][d0], s[1], 0, 0, 0); }
            bf16x8 pf[2][2];
#pragma unroll
            for (int qb = 0; qb < 2; ++qb) {
                float ma = max3f(s[qb][0], s[qb][1], s[qb][2]), mb = max3f(s[qb][3], s[qb][4], s[qb][5]);
                ma = max3f(ma, s[qb][6], s[qb][7]); mb = max3f(mb, s[qb][8], s[qb][9]); ma = max3f(ma, s[qb][10], s[qb][11]); mb = max3f(mb, s[qb][12], s[qb][13]); ma = max3f(ma, s[qb][14], s[qb][15]);
                const float mx = xh_max(fmaxf(ma, mb));
                if (__any(mx > mref[qb] + RESC_THR)) {
                    const float nm = fmaxf(mx, mref[qb]), f = ex2(mref[qb] - nm); mref[qb] = nm; lsum[qb] *= f;
#pragma unroll
                    for (int db = 0; db < 2; ++db)
#pragma unroll
                        for (int r = 0; r < 16; ++r) o[qb][db][r] *= f;
                }
                const float mr = mref[qb]; float sum = 0.f;
#pragma unroll
                for (int r = 0; r < 16; ++r) { const float p = ex2(s[qb][r] - mr); s[qb][r] = p; sum += p; }
                lsum[qb] += sum;
#pragma unroll
                for (int ss = 0; ss < 2; ++ss)
                    pf[qb][ss] = __builtin_bit_cast(bf16x8, (u32x4){pk2(s[qb][8 * ss + 0], s[qb][8 * ss + 1]), pk2(s[qb][8 * ss + 2], s[qb][8 * ss + 3]), pk2(s[qb][8 * ss + 4], s[qb][8 * ss + 5]), pk2(s[qb][8 * ss + 6], s[qb][8 * ss + 7])});
            }
#pragma unroll
            for (int db = 0; db < 2; ++db)
#pragma unroll
                for (int ss = 0; ss < 2; ++ss) {
                    o[0][db] = __builtin_amdgcn_mfma_f32_32x32x16_bf16(vfr[db][ss], pf[0][ss], o[0][db], 0, 0, 0);
                    o[1][db] = __builtin_amdgcn_mfma_f32_32x32x16_bf16(vfr[db][ss], pf[1][ss], o[1][db], 0, 0, 0); }
        }
#undef LOAD_K
#undef LOAD_V
        if (t + 1 < SEQ / 128) ATT_STAGE(buf ^ 1);
        __syncthreads();
    }
#undef ATT_LOAD
#undef ATT_STAGE
#pragma unroll
    for (int qb = 0; qb < 2; ++qb) { const float lt = xh_sum(lsum[qb]); const float inv = 1.f / lt;
#pragma unroll
        for (int db = 0; db < 2; ++db)
#pragma unroll
            for (int r = 0; r < 16; ++r) o[qb][db][r] *= inv; }
    float rs[2] = {1.f, 1.f};
    if constexpr (DIFF) {
        LAS float* X = (LAS float*)(lds + LDS_COMB) + (wq * 64) * 64 + lane;
        if (comp == 1) {
#pragma unroll
            for (int qb = 0; qb < 2; ++qb)
#pragma unroll
                for (int db = 0; db < 2; ++db)
#pragma unroll
                    for (int r = 0; r < 16; ++r) X[((qb * 2 + db) * 16 + r) * 64] = o[qb][db][r];
        }
        __syncthreads();
        if (comp == 1) return;
#pragma unroll
        for (int qb = 0; qb < 2; ++qb) { float ss = 0.f;
#pragma unroll
            for (int db = 0; db < 2; ++db)
#pragma unroll
                for (int r = 0; r < 16; ++r) { const float x = o[qb][db][r] - lam * X[((qb * 2 + db) * 16 + r) * 64]; o[qb][db][r] = x; ss += x * x; }
            ss = xh_sum(ss);
            rs[qb] = oscale / sqrtf(ss * (1.f / 64.f) + LN_EPS); }
    }
#pragma unroll
    for (int qb = 0; qb < 2; ++qb) { bf16* op = cat + (qrow + 32 * qb) * DM + ooff;
#pragma unroll
        for (int db = 0; db < 2; ++db)
#pragma unroll
            for (int r4 = 0; r4 < 4; ++r4) { const int d = 32 * db + 8 * r4 + 4 * hi;
                float v0 = o[qb][db][4 * r4 + 0], v1 = o[qb][db][4 * r4 + 1], v2 = o[qb][db][4 * r4 + 2], v3 = o[qb][db][4 * r4 + 3];
                if constexpr (DIFF) { const f32x4 gg = *(const f32x4*)(subg + d); const float q = rs[qb]; v0 *= q * gg.x; v1 *= q * gg.y; v2 *= q * gg.z; v3 *= q * gg.w; }
                u32x2 w; w.x = pk2(v0, v1); w.y = pk2(v2, v3); *(u32x2*)(op + d) = w; } }
}

constexpr int GROW = 272, GGRP = 8 * GROW + 16;
__device__ __forceinline__ void gate_unit(LAS unsigned char* lds, const bf16* __restrict__ h, bf16* __restrict__ cat, const bf16* __restrict__ wsb, const float* __restrict__ bs, int b, int n, int g) {
    int tid_ = threadIdx.x; asm volatile("" : "+v"(tid_));
    const int tid = tid_, lane = tid & 63, wid = tid >> 6, r32 = lane & 31, hi = lane >> 5;
    const size_t R0 = (size_t)b * SEQ + n * 128;
    const int pb = wid & 3, db = wid >> 2;
    const int p = 32 * pb + r32;
    u32x4 vst[2];
#pragma unroll
    for (int i = 0; i < 2; ++i) { const int idx = tid + NT * i, row = idx >> 3, ch = idx & 7; vst[i] = *(const u32x4*)(h + (R0 + row) * INC + 1792 + 64 * g + ch * 8); }
    const bf16* wrow = wsb + ((size_t)(g * 128 + p)) * 128 + 8 * hi;
    bf16x8 wf[8];
#pragma unroll
    for (int ks = 0; ks < 8; ++ks) wf[ks] = *(const bf16x8*)(wrow + 16 * ks);
    const float bias = bs[g * 128 + p];
    const bf16* up = h + (R0 + p) * INC + 1536 + 64 * g; bf16* op = cat + (R0 + p) * DM + 768 + 64 * g;
    u32x2 uu[4];
#pragma unroll
    for (int r4 = 0; r4 < 4; ++r4) uu[r4] = *(const u32x2*)(up + 32 * db + 8 * r4 + 4 * hi);
#pragma unroll
    for (int i = 0; i < 2; ++i) { const int idx = tid + NT * i, row = idx >> 3, ch = idx & 7; const u32x4 v = vst[i];
#pragma unroll
        for (int j = 0; j < 8; ++j) *(LAS unsigned short*)(lds + ch * GGRP + j * GROW + row * 2) = (unsigned short)(v[j >> 1] >> (16 * (j & 1))); }
    __syncthreads();
    f32x16 acc;
#pragma unroll
    for (int r = 0; r < 16; ++r) acc[r] = 0.f;
#pragma unroll
    for (int ks = 0; ks < 8; ++ks) {
        const bf16x8 a = *(const LAS bf16x8*)(lds + (4 * db + (r32 >> 3)) * GGRP + (r32 & 7) * GROW + 32 * ks + 16 * hi);
        acc = __builtin_amdgcn_mfma_f32_32x32x16_bf16(a, wf[ks], acc, 0, 0, 0);
    }
#pragma unroll
    for (int r4 = 0; r4 < 4; ++r4) { const int d = 32 * db + 8 * r4 + 4 * hi; const u32x2 u2 = uu[r4];
        u32x2 w; w.x = pk2(bflo(u2.x) * (acc[4 * r4 + 0] + bias), bfhi(u2.x) * (acc[4 * r4 + 1] + bias)); w.y = pk2(bflo(u2.y) * (acc[4 * r4 + 2] + bias), bfhi(u2.y) * (acc[4 * r4 + 3] + bias));
        *(u32x2*)(op + d) = w; }
    __syncthreads();
}

__device__ __forceinline__ void p2_mixers(const Ctx& F, LAS unsigned char* lds, int l, int simd_rank) {
    const bf16* h = (const bf16*)(F.ws + WS_H); bf16* cat = (bf16*)(F.ws + WS_CAT);
    const float lam_init = l == 0 ? 0.2f : l == 1 ? 0.35550907f : l == 2 ? 0.47071302f : 0.55605820f;
    const float* lq = F.in[3] + l * 128; float d1 = 0.f, d2 = 0.f;
    for (int i = 0; i < 32; ++i) { d1 += lq[i] * lq[32 + i]; d2 += lq[64 + i] * lq[96 + i]; }
    const float lam = expf(d1) - expf(d2) + lam_init;
    const float* subg = F.in[4] + l * 64;
    if (simd_rank == 0) __builtin_amdgcn_s_setprio(2);
    for (int u = F.vcu; u < BATCH * 4 * 8; u += F.G) { const int qb = u & 7, hh = (u >> 3) & 3, b = u >> 5;
        attn_unit<true>(lds, h, cat, b, qb * 256, 64 * hh, 256 + 64 * hh, 512 + 64 * hh, 64 * hh, lam, 1.f - lam_init, subg); }
    for (int u = F.vcu; u < BATCH * 8 * 4; u += F.G) { const int q4 = u & 3, j = (u >> 2) & 7, b = u >> 5;
        attn_unit<false>(lds, h, cat, b, q4 * 512, 768 + 64 * j, 1280 + 64 * (j >> 2), 1408 + 64 * (j >> 2), 256 + 64 * j, 0.f, 1.f, subg); }
    __builtin_amdgcn_s_setprio(0);
    const bf16* wsb = (const bf16*)(F.ws + WS_WSB) + (size_t)l * 4 * 128 * 128; const float* bs = F.in[10] + l * 512;
    for (int u = F.vcu; u < BATCH * 16 * 4; u += F.G) { const int g = u & 3, n = (u >> 2) & 15, b = u >> 6;
        gate_unit(lds, h, cat, wsb, bs, b, n, g); }
}

__global__ void __launch_bounds__(NT, 2) fwd_megakernel(Args args) {
    extern __shared__ __attribute__((aligned(16))) unsigned char lds_raw[];
    LAS unsigned char* lds = (LAS unsigned char*)lds_raw;
    cg::grid_group grid = cg::this_grid();
    Ctx F;
    F.in = args.in; F.out = args.out; F.ws = args.ws;
    F.tid = threadIdx.x; F.lane = F.tid & 63; F.wave = __builtin_amdgcn_readfirstlane(F.tid >> 6);
    F.G = gridDim.x; { const int bx = blockIdx.x; F.vcu = (F.G % 8 == 0) ? (bx % 8) * (F.G / 8) + bx / 8 : bx; }
    bf16* xb = (bf16*)(F.ws + WS_XB); bf16* h = (bf16*)(F.ws + WS_H); bf16* cat = (bf16*)(F.ws + WS_CAT); bf16* hid = (bf16*)(F.ws + WS_HID);

#ifndef NO_P0
    p0_prologue(F, lds);
#endif
    if (F.tid < 16) ((LAS unsigned*)(lds + MISC_OFF))[F.tid] = 0u;
    if (blockIdx.x == 0) for (int i = F.tid; i < XCD_BAR_WORDS; i += NT) __hip_atomic_store((unsigned*)(F.ws + WS_BAR) + i, 0u, __ATOMIC_RELAXED, __HIP_MEMORY_SCOPE_AGENT);
    grid.sync();
    int simd_rank;
    { const unsigned simd = (unsigned)__builtin_amdgcn_s_getreg((1 << 11) | (4 << 6) | 4) & 3u;
      unsigned r = 0; if (F.lane == 0) r = __hip_atomic_fetch_add((LAS unsigned*)(lds + MISC_OFF) + 4 + simd, 1u, __ATOMIC_RELAXED, __HIP_MEMORY_SCOPE_WORKGROUP);
      simd_rank = (int)(__builtin_amdgcn_readfirstlane(r) & 1u); }
    const XcdBarrier bar = xcd_barrier_post((unsigned*)(F.ws + WS_BAR), (volatile LAS unsigned*)(lds + MISC_OFF));
    for (int l = 0; l < DEPTH; ++l) {
        unsigned char* wl = F.ws + WS_W + (size_t)l * W_LAYER;
#ifndef NO_P1
        {
            pg8::Gemm g{xb, (const bf16*)(wl + W_IN), MROWS, INC, DM}; pg8::StaticOrder S; S.init(MROWS, INC, F.G, (int)blockIdx.x);
            EpiInProj E{h, (const f32x2*)(F.ws + WS_TAB)};
            pg8::gemm_phase<EpiInProj, pg8::StaticOrder, true, true>(lds, g, S, E);
        }
#endif
        xcd_barrier(bar);
#ifndef NO_P1B
        p1b_postproc(F, l);
#endif
        xcd_barrier(bar);
#ifndef NO_P2
        p2_mixers(F, lds, l, simd_rank);
#endif
        xcd_barrier(bar);
#ifndef NO_P3
        {
            pg8::Gemm g{cat, (const bf16*)(wl + W_O), MROWS, DM, DM}; pg8::StaticOrder S; S.init(MROWS, DM, F.G, (int)blockIdx.x);
            EpiRes E{l == 0 ? F.in[0] : (const float*)F.out, F.out, l == 0 ? nullptr : (const f32x2*)(F.ws + WS_STATS), F.in[16] + (l - 1) * DM, F.in[17] + (l - 1) * DM};
            pg8::gemm_phase<EpiRes, pg8::StaticOrder, true, true>(lds, g, S, E);
        }
#endif
        xcd_barrier(bar);
#ifndef NO_LN
        ln_pass<false>(F, F.in[11] + l * DM, F.in[12] + l * DM);
#endif
        xcd_barrier(bar);
#ifndef NO_P4
        {
            pg8::Gemm g{xb, (const bf16*)(wl + W_GU), MROWS, GU, DM}; pg8::StaticOrder S; S.init(MROWS, GU, F.G, (int)blockIdx.x);
            EpiSwiglu E{hid};
            pg8::gemm_phase<EpiSwiglu, pg8::StaticOrder, true, true>(lds, g, S, E);
        }
#endif
        xcd_barrier(bar);
#ifndef NO_P5
        {
            pg8::Gemm g{hid, (const bf16*)(wl + W_D), MROWS, DM, FFH}; pg8::StaticOrder S; S.init(MROWS, DM, F.G, (int)blockIdx.x);
            EpiRes E{(const float*)F.out, F.out, (const f32x2*)(F.ws + WS_STATS), F.in[11] + l * DM, F.in[12] + l * DM};
            pg8::gemm_phase<EpiRes, pg8::StaticOrder, true, true>(lds, g, S, E);
        }
#endif
        xcd_barrier(bar);
#ifndef NO_LN
        if (l == DEPTH - 1) ln_pass<true>(F, F.in[16] + l * DM, F.in[17] + l * DM); else ln_pass<false>(F, F.in[16] + l * DM, F.in[17] + l * DM);
#endif
        xcd_barrier(bar);
    }
}

extern "C" void kernel_launch(void* const* d_in, const int* in_sizes, int n_in, void* d_out, int out_size, void* d_ws, size_t ws_size, hipStream_t stream) {
    static int grid = 0;
    if (grid == 0) {
        if (n_in != 18 || in_sizes[0] != MROWS * DM || out_size != MROWS * DM || ws_size < WS_END) { fprintf(stderr, "kernel_launch: unexpected shapes (n_in %d, ws %zu)\n", n_in, ws_size); grid = -1; return; }
        int dev = 0, cus = 0, per_cu = 0;
        hipGetDevice(&dev); hipDeviceGetAttribute(&cus, hipDeviceAttributeMultiprocessorCount, dev);
        hipFuncSetAttribute((const void*)fwd_megakernel, hipFuncAttributeMaxDynamicSharedMemorySize, LDS_BYTES);
        hipOccupancyMaxActiveBlocksPerMultiprocessor(&per_cu, (const void*)fwd_megakernel, NT, LDS_BYTES);
        if (per_cu < 1) per_cu = 1;
        (void)hipGetLastError();
        grid = cus * per_cu;
    }
    if (grid < 0) return;
    Args a{};
    for (int i = 0; i < 18; ++i) a.in[i] = (const float*)d_in[i];
    a.out = (float*)d_out; a.ws = (unsigned char*)d_ws;
    void* kargs[] = {&a};
    hipError_t e = hipLaunchCooperativeKernel((const void*)fwd_megakernel, dim3(grid), dim3(NT), kargs, LDS_BYTES, stream);
    if (e != hipSuccess) fprintf(stderr, "cooperative launch failed: %s (grid %d)\n", hipGetErrorString(e), grid);
}
```

```cpp
#include <hip/hip_runtime.h>
#include <hip/hip_cooperative_groups.h>
#include <cstdio>
#include <cstdint>
namespace cg = cooperative_groups;
namespace pg8 {
#define PG8_LAS __attribute__((address_space(3)))
typedef unsigned short bf16_t;
typedef short bf16x8 __attribute__((ext_vector_type(8)));
typedef float f32x4 __attribute__((ext_vector_type(4)));
typedef unsigned u32x4 __attribute__((ext_vector_type(4)));
constexpr int BM = 256, BK = 64, HALF = 128, HTB = HALF * BK * 2  , STAGE_BYTES = 8 * HTB, NXCD = 8, WGM = 8;

__host__ __device__ __forceinline__ int lds_byte(int r, int c) { const int st = (r >> 4) * 2 + (c >> 5), rr = r & 15, cc = c & 31, ob = rr * 64 + cc * 2; return st * 1024 + (ob ^ (((ob >> 9) & 1) << 5)); }
__host__ __device__ __forceinline__ void stage_rc(int b, int& R, int& C) { const int st = b / 1024, sb = b % 1024, swz = sb ^ (((sb >> 9) & 1) << 5); R = (st >> 1) * 16 + swz / 64; C = (st & 1) * 32 + (swz % 64) / 2; }
__host__ __device__ __forceinline__ int perm32(int rho) { const int n = rho >> 4, i = rho & 15; return 8 * (i >> 2) + 4 * n + (i & 3); }

struct Unit { int pm, pn; };
struct Gemm { const bf16_t* A; const bf16_t* Bt; int M, N, K; };

struct StaticOrder {
    int nM, nN, nwg, G, c;
    __host__ __device__ void init(int M, int N, int G_, int c_) { nM = M / BM; nN = N / BM; nwg = nM * nN; G = G_; c = c_; }
    __host__ __device__ bool next(int i, Unit& u) const {
        const long L = (long)i * G + c; if (L >= nwg) return false;
        int wgid = (int)L; { const int q = nwg / NXCD, r = nwg % NXCD, xcd = wgid % NXCD, off = wgid / NXCD; wgid = (xcd < r ? xcd * (q + 1) : r * (q + 1) + (xcd - r) * q) + off; }
        const int nig = WGM * nN, gid = wgid / nig, fm = gid * WGM, gsz = (nM - fm) < WGM ? (nM - fm) : WGM;
        u.pm = fm + ((wgid % nig) % gsz); u.pn = (wgid % nig) / gsz; return true;
    }
    __device__ __forceinline__ void a_ready(const Unit&) const {}
    __device__ __forceinline__ void done(const Unit&) const {}
};

__device__ __forceinline__ unsigned cvt_pk_bf16(float lo, float hi) { unsigned r; asm volatile("v_cvt_pk_bf16_f32 %0, %1, %2" : "=v"(r) : "v"(lo), "v"(hi)); return r; }
typedef float f32x2 __attribute__((ext_vector_type(2)));
__device__ __forceinline__ f32x2 gelu_pk(f32x2 v) {
    const f32x2 av = __builtin_elementwise_abs(v), d = av * 0.2316418882f + 1.0f;
    f32x2 t; t.x = __builtin_amdgcn_rcpf(d.x); t.y = __builtin_amdgcn_rcpf(d.y);
    f32x2 q = t * 0.5307027145f + (-0.7265760135f); q = q * t + 0.7107068705f; q = q * t + (-0.142248368f); q = q * t + 0.127414796f; q = q * t;
    const f32x2 s = (v * v) * (-0.72134752044f);
    f32x2 e; e.x = __builtin_amdgcn_exp2f(s.x); e.y = __builtin_amdgcn_exp2f(s.y);
    const f32x2 m = v * (q * e), r = v - m;
    f32x2 o; o.x = v.x < 0.f ? m.x : r.x; o.y = v.y < 0.f ? m.y : r.y; return o;
}

template <int ACT  > struct EpiBf16 {
    static constexpr bool PERM = true, AFTER_DRAIN = false; static_assert(ACT == 0 || ACT == 1, "EpiBf16: ACT is 0 (none) or 1 (gelu_pk)");
    bf16_t* O; int ldc; const float* bias; int split_cols; size_t split_stride; float scale0;
    __device__ __forceinline__ void operator()(const f32x4 (&acc)[2][2][4][2], const Unit& u, int wr, int wc, int fr, int fq) const {
        const int row0 = u.pm * BM + wr * 64 + fr; int colt = u.pn * BM; bf16_t* base = O;
        float sc = 1.f; if (split_cols) { const int t = colt / split_cols; base += (size_t)t * split_stride; colt -= t * split_cols; if (t == 0) sc = scale0; }
        const int col0 = colt + wc * 32 + 8 * fq, bcol0 = u.pn * BM + wc * 32 + 8 * fq;
        f32x4 bv[2][2];
#pragma unroll
        for (int bj = 0; bj < 2; ++bj)
#pragma unroll
            for (int n = 0; n < 2; ++n) bv[bj][n] = bias ? *(const f32x4*)(bias + bcol0 + bj * HALF + 4 * n) : (f32x4){0.f, 0.f, 0.f, 0.f};
#pragma unroll
        for (int ai = 0; ai < 2; ++ai)
#pragma unroll
            for (int m = 0; m < 4; ++m) { bf16_t* rowp = base + (size_t)(row0 + ai * HALF + m * 16) * ldc + col0;
#pragma unroll
                for (int bj = 0; bj < 2; ++bj) { f32x4 v0 = acc[ai][bj][m][0] + bv[bj][0], v1 = acc[ai][bj][m][1] + bv[bj][1];
                    if (ACT == 1) { f32x2 a = gelu_pk((f32x2){v0[0], v0[1]}), b = gelu_pk((f32x2){v0[2], v0[3]}), c = gelu_pk((f32x2){v1[0], v1[1]}), d = gelu_pk((f32x2){v1[2], v1[3]});
                        v0 = (f32x4){a.x, a.y, b.x, b.y}; v1 = (f32x4){c.x, c.y, d.x, d.y}; }
                    v0 = v0 * sc; v1 = v1 * sc; u32x4 w; w.x = cvt_pk_bf16(v0[0], v0[1]); w.y = cvt_pk_bf16(v0[2], v0[3]); w.z = cvt_pk_bf16(v1[0], v1[1]); w.w = cvt_pk_bf16(v1[2], v1[3]);
                    *(u32x4*)(rowp + bj * HALF) = w; } }
    }
};
template <class Epi, class Sched, bool ALIGN_EPI = false, bool SP2 = false>
__device__ __forceinline__ void gemm_phase(PG8_LAS unsigned char* lds, const Gemm g, const Sched& S, const Epi& E) {
    int tid_ = threadIdx.x; asm volatile("" : "+v"(tid_));
    const int tid = tid_, wid = __builtin_amdgcn_readfirstlane(tid >> 6), lane = tid & 63, wr = wid >> 2, wc = wid & 3, fr = lane & 15, fq = lane >> 4;
    const int K = g.K, nt = K / BK;
    unsigned voffA[2], voffB[2];
#pragma unroll
    for (int i = 0; i < 2; ++i) { int R, C; stage_rc(tid * 16 + i * 8192, R, C); const int Rb = Epi::PERM ? ((R & ~31) + perm32(R & 31)) : R;
        voffA[i] = (unsigned)(R * K + C) * 2u; voffB[i] = (unsigned)(Rb * K + C) * 2u; }
    const size_t kstep = (size_t)(BK * 2);
    const size_t hstep = (size_t)HALF * K * 2;
    const size_t tstep = 2 * hstep;
    const unsigned ldsw = (unsigned)wid * 1024u;
    const int aoff = lds_byte(wr * 64 + fr, fq * 8), boff = lds_byte(wc * 32 + fr, fq * 8);
#define PG8_SA(b, h) (((b) * 2 + (h)) * HTB)
#define PG8_SB(b, h) ((4 + (b) * 2 + (h)) * HTB)
#define PG8_STAGE(bufoff, gbase, voff) do { _Pragma("unroll") for (int _i = 0; _i < 2; ++_i) \
        __builtin_amdgcn_global_load_lds((const unsigned*)((const char*)(gbase) + (voff)[_i]), (PG8_LAS unsigned*)(lds + (bufoff) + ldsw + _i * 8192), 16, 0, 0); } while (0)
#define PG8_LDA(dst, b, h) do { _Pragma("unroll") for (int m = 0; m < 4; ++m) _Pragma("unroll") for (int k = 0; k < 2; ++k) dst[m][k] = *(const PG8_LAS bf16x8*)(lds + PG8_SA(b, h) + aoff + m * 2048 + k * 1024); } while (0)
#define PG8_LDB(dst, b, h) do { _Pragma("unroll") for (int n = 0; n < 2; ++n) _Pragma("unroll") for (int k = 0; k < 2; ++k) dst[n][k] = *(const PG8_LAS bf16x8*)(lds + PG8_SB(b, h) + boff + n * 2048 + k * 1024); } while (0)
#define PG8_MMA(ai, bj, At, Bt) do { __builtin_amdgcn_s_setprio(1); _Pragma("unroll") for (int m = 0; m < 4; ++m) _Pragma("unroll") for (int n = 0; n < 2; ++n) _Pragma("unroll") for (int k = 0; k < 2; ++k) \
        acc[ai][bj][m][n] = __builtin_amdgcn_mfma_f32_16x16x32_bf16(Bt[n][k], At[m][k], acc[ai][bj][m][n], 0, 0, 0); __builtin_amdgcn_s_setprio(0); } while (0)
#define PG8_WAIT_V(n) asm volatile("s_waitcnt vmcnt(" #n ")" ::: "memory")
#define PG8_WAIT_L(n) asm volatile("s_waitcnt lgkmcnt(" #n ")" ::: "memory")
#define PG8_BAR __builtin_amdgcn_s_barrier()
#define PG8_SCHED __builtin_amdgcn_sched_barrier(0)
    Unit cur, nxt; int ui = 0;
    if (!S.next(0, cur)) return;
    f32x4 acc[2][2][4][2];
#pragma unroll
    for (int a = 0; a < 2; ++a)
#pragma unroll
        for (int b = 0; b < 2; ++b)
#pragma unroll
            for (int m = 0; m < 4; ++m)
#pragma unroll
                for (int n = 0; n < 2; ++n) acc[a][b][m][n] = (f32x4){0.f, 0.f, 0.f, 0.f};
    bf16x8 At[4][2], B0[2][2], B1[2][2];
    const char* cA = (const char*)g.A + (size_t)cur.pm * tstep; const char* cB = (const char*)g.Bt + (size_t)cur.pn * tstep;
    S.a_ready(cur);
    if constexpr (SP2) {
        PG8_STAGE(PG8_SB(0, 0), cB, voffB); PG8_STAGE(PG8_SB(0, 1), cB + hstep, voffB); PG8_STAGE(PG8_SA(0, 0), cA, voffA); PG8_STAGE(PG8_SA(0, 1), cA + hstep, voffA);
        if (wr == 1) PG8_BAR;
        PG8_WAIT_V(2); PG8_BAR;
        PG8_STAGE(PG8_SB(1, 0), cB + kstep, voffB); PG8_STAGE(PG8_SA(1, 0), cA + kstep, voffA); PG8_STAGE(PG8_SB(1, 1), cB + hstep + kstep, voffB);
        PG8_WAIT_V(6); PG8_BAR;
    } else {
        PG8_STAGE(PG8_SB(0, 0), cB, voffB); PG8_STAGE(PG8_SA(0, 0), cA, voffA); PG8_STAGE(PG8_SB(0, 1), cB + hstep, voffB); PG8_STAGE(PG8_SA(0, 1), cA + hstep, voffA);
        if (wr == 1) PG8_BAR;
        PG8_WAIT_V(4); PG8_BAR;
        PG8_STAGE(PG8_SB(1, 0), cB + kstep, voffB); PG8_STAGE(PG8_SA(1, 0), cA + kstep, voffA); PG8_STAGE(PG8_SB(1, 1), cB + hstep + kstep, voffB);
        PG8_WAIT_V(6); PG8_BAR;
    }
    for (;;) {
        const bool has_next = S.next(ui + 1, nxt);
        const char* nA = has_next ? (const char*)g.A + (size_t)nxt.pm * tstep : cA; const char* nB = has_next ? (const char*)g.Bt + (size_t)nxt.pn * tstep : cB;
        for (int t = 0; t < nt; t += 2) {
            const bool last = (t == nt - 2);
            const char* a1 = cA + (size_t)(t + 1) * kstep;
            const char* a2 = last ? nA : cA + (size_t)(t + 2) * kstep; const char* b2 = last ? nB : cB + (size_t)(t + 2) * kstep;
            const char* a3 = a2 + kstep; const char* b3 = b2 + kstep;
            if (last && has_next) S.a_ready(nxt);
            if constexpr (SP2) {
            PG8_LDB(B0, 0, 0); PG8_LDB(B1, 0, 1); PG8_SCHED; PG8_LDA(At, 0, 0); PG8_STAGE(PG8_SA(1, 1), a1 + hstep, voffA);
            PG8_WAIT_V(8); PG8_WAIT_L(0); PG8_BAR; PG8_MMA(0, 0, At, B0); PG8_MMA(0, 1, At, B1); PG8_BAR; PG8_SCHED;
            PG8_LDA(At, 0, 1); PG8_STAGE(PG8_SB(0, 0), b2, voffB); PG8_STAGE(PG8_SB(0, 1), b2 + hstep, voffB); PG8_STAGE(PG8_SA(0, 0), a2, voffA);
            PG8_WAIT_V(8); PG8_WAIT_L(0); PG8_BAR; PG8_MMA(1, 0, At, B0); PG8_MMA(1, 1, At, B1); PG8_BAR; PG8_SCHED;
            PG8_LDB(B0, 1, 0); PG8_LDB(B1, 1, 1); PG8_SCHED; PG8_LDA(At, 1, 0); PG8_STAGE(PG8_SA(0, 1), a2 + hstep, voffA);
            PG8_WAIT_V(8); PG8_WAIT_L(0); PG8_BAR; PG8_MMA(0, 0, At, B0); PG8_MMA(0, 1, At, B1); PG8_BAR; PG8_SCHED;
            PG8_LDA(At, 1, 1); PG8_STAGE(PG8_SB(1, 0), b3, voffB); PG8_STAGE(PG8_SB(1, 1), b3 + hstep, voffB); PG8_STAGE(PG8_SA(1, 0), a3, voffA);
            PG8_WAIT_V(8); PG8_WAIT_L(0); PG8_BAR; PG8_MMA(1, 0, At, B0); PG8_MMA(1, 1, At, B1); PG8_BAR; PG8_SCHED;
            } else {
            PG8_LDB(B0, 0, 0); PG8_SCHED; PG8_LDA(At, 0, 0); PG8_STAGE(PG8_SA(1, 1), a1 + hstep, voffA);
            PG8_WAIT_L(8); PG8_BAR; PG8_WAIT_L(0); PG8_MMA(0, 0, At, B0); PG8_BAR; PG8_SCHED;
            PG8_LDB(B1, 0, 1); PG8_STAGE(PG8_SB(0, 0), b2, voffB);
            PG8_BAR; PG8_WAIT_L(0); PG8_MMA(0, 1, At, B1); PG8_BAR;
            PG8_LDA(At, 0, 1); PG8_STAGE(PG8_SA(0, 0), a2, voffA);
            PG8_BAR; PG8_WAIT_L(0); PG8_MMA(1, 0, At, B0); PG8_BAR; PG8_SCHED;
            PG8_STAGE(PG8_SB(0, 1), b2 + hstep, voffB);
            PG8_WAIT_V(6); PG8_BAR; PG8_MMA(1, 1, At, B1); PG8_BAR;
            PG8_LDB(B0, 1, 0); PG8_SCHED; PG8_LDA(At, 1, 0); PG8_STAGE(PG8_SA(0, 1), a2 + hstep, voffA);
            PG8_WAIT_L(8); PG8_BAR; PG8_WAIT_L(0); PG8_MMA(0, 0, At, B0); PG8_BAR; PG8_SCHED;
            PG8_LDB(B1, 1, 1); PG8_STAGE(PG8_SB(1, 0), b3, voffB);
            PG8_BAR; PG8_WAIT_L(0); PG8_MMA(0, 1, At, B1); PG8_BAR;
            PG8_LDA(At, 1, 1); PG8_STAGE(PG8_SA(1, 0), a3, voffA);
            PG8_BAR; PG8_WAIT_L(0); PG8_MMA(1, 0, At, B0); PG8_BAR; PG8_SCHED;
            PG8_STAGE(PG8_SB(1, 1), b3 + hstep, voffB);
            PG8_WAIT_V(6); PG8_BAR; PG8_MMA(1, 1, At, B1); PG8_BAR;
            }
        }
        if constexpr (ALIGN_EPI) { if (wr == 0) PG8_BAR; }
        if constexpr (!Epi::AFTER_DRAIN) { E(acc, cur, wr, wc, fr, fq); S.done(cur); }
        if (!has_next) break;
#pragma unroll
        for (int a = 0; a < 2; ++a)
#pragma unroll
            for (int b = 0; b < 2; ++b)
#pragma unroll
                for (int m = 0; m < 4; ++m)
#pragma unroll
                    for (int n = 0; n < 2; ++n) acc[a][b][m][n] = (f32x4){0.f, 0.f, 0.f, 0.f};
        cur = nxt; cA = nA; cB = nB; ++ui;
        if constexpr (ALIGN_EPI) { if (wr == 1) PG8_BAR; }
    }
    PG8_WAIT_V(0);
    if constexpr (!ALIGN_EPI) { if (wr == 0) PG8_BAR; }
    PG8_BAR;
    if constexpr (Epi::AFTER_DRAIN) { E.fused(acc, cur, wr, wc, fr, fq, lds, wid, lane); S.done(cur); }
#undef PG8_SA
#undef PG8_SB
#undef PG8_STAGE
#undef PG8_LDA
#undef PG8_LDB
#undef PG8_MMA
#undef PG8_WAIT_V
#undef PG8_WAIT_L
#undef PG8_BAR
#undef PG8_SCHED
}
}

constexpr int BATCH = 32, SEQ = 2048, DM = 1024, DEPTH = 4, MROWS = BATCH * SEQ;
constexpr int INC = 2048, FFH = 2816, GU = 2 * FFH;
constexpr float LN_EPS = 1e-5f;
constexpr float ALPHA = 1.6817928305074290f;
constexpr float LOG2E = 1.4426950408889634f;
constexpr float SCALE_A = 0.17677669529663687f * LOG2E;
constexpr float SCALE_B = 0.125f * LOG2E;
constexpr int NT = 512;

#define LAS __attribute__((address_space(3)))
typedef unsigned short bf16;
typedef short bf16x8 __attribute__((ext_vector_type(8)));
typedef float f32x4 __attribute__((ext_vector_type(4)));
typedef float f32x16 __attribute__((ext_vector_type(16)));
typedef unsigned u32x4 __attribute__((ext_vector_type(4)));
typedef unsigned u32x2 __attribute__((ext_vector_type(2)));
typedef float f32x2 __attribute__((ext_vector_type(2)));

constexpr size_t MiB = 1u << 20;
constexpr size_t WS_TAB = 1 * MiB;
constexpr size_t WS_STATS = 3 * MiB;
constexpr size_t WS_WSB = 2 * MiB;
constexpr size_t WS_W = 4 * MiB, W_LAYER = 23 * MiB, W_IN = 0, W_O = 4 * MiB, W_GU = 6 * MiB, W_D = 17 * MiB;
constexpr size_t WS_XB = 96 * MiB;
constexpr size_t WS_H = 224 * MiB;
constexpr size_t WS_CAT = 480 * MiB;
constexpr size_t WS_HID = 608 * MiB;
constexpr size_t WS_END = 960 * MiB;
constexpr int LDS_BYTES = 147456;
constexpr int MISC_OFF = 147456 - 64;
constexpr size_t WS_BAR = 0;
#define XB_TMO      128
#define XB_XCNT(j)  (256  + 64 * (j))
#define XB_XSUB(j)  (1280 + 64 * (j))
#define XB_XGEN(j)  (2304 + 64 * (j))
#define XB_TOP      3328
#define XB_TOPGEN   3392
#define XCD_BAR_WORDS 3456
#define XB_SPIN_CAP (1u << 22)

__device__ __forceinline__ unsigned xb_ld(unsigned* p)              { return __hip_atomic_load(p, __ATOMIC_RELAXED, __HIP_MEMORY_SCOPE_AGENT); }
__device__ __forceinline__ unsigned xb_add(unsigned* p, unsigned v) { return __hip_atomic_fetch_add(p, v, __ATOMIC_RELAXED, __HIP_MEMORY_SCOPE_AGENT); }
__device__ __forceinline__ unsigned xb_xcc_id() { return (unsigned)__builtin_amdgcn_s_getreg((3 << 11) | 20) & 0xFu; }
#define XB_SPIN(cond, bar) do { unsigned _sp = 0; while (cond) { __builtin_amdgcn_s_sleep(1); \
    if ((++_sp & 255u) == 0u) { if (xb_ld(&(bar)[XB_TMO])) break; if (_sp > XB_SPIN_CAP) { atomicAdd(&(bar)[XB_TMO], 1u); break; } } } } while (0)

struct XcdBarrier {
    unsigned* bar; unsigned x;
    volatile LAS unsigned* st;
};

__device__ __forceinline__ XcdBarrier xcd_barrier_post(unsigned* bar, volatile LAS unsigned* st) {
    XcdBarrier b; b.bar = bar; b.x = xb_xcc_id(); b.st = st;
    if (threadIdx.x == 0) (void)xb_add(&bar[XB_XCNT(b.x)], 1u);
    return b;
}
__device__ __forceinline__ void xcd_barrier_complete(unsigned* bar, unsigned x, unsigned& nloc, unsigned& nx) {
    const unsigned G = gridDim.x * gridDim.y * gridDim.z;
    unsigned sum, cnt, mine, sp = 0u;
    for (;;) {
        sum = 0u; cnt = 0u; mine = 0u;
#pragma unroll
        for (unsigned j = 0; j < 16; ++j) { const unsigned c = xb_ld(&bar[XB_XCNT(j)]); sum += c; cnt += (c > 0u) ? 1u : 0u; mine = (j == x) ? c : mine; }
        if (sum == G) break;
        __builtin_amdgcn_s_sleep(1);
        if ((++sp & 255u) == 0u) { if (xb_ld(&bar[XB_TMO])) break; if (sp > XB_SPIN_CAP) { atomicAdd(&bar[XB_TMO], 1u); break; } }
    }
    nloc = mine > 0u ? mine : 1u; nx = cnt > 0u ? cnt : 1u;
}

__device__ __forceinline__ void xcd_barrier(const XcdBarrier& b) {
    asm volatile("s_waitcnt vmcnt(0)" ::: "memory");
    __syncthreads();
    if (threadIdx.x == 0) {
        unsigned* bar = b.bar;
        __builtin_amdgcn_s_waitcnt(0);
        unsigned nloc = b.st[0], nx = b.st[1];
        if (nloc == 0u) { xcd_barrier_complete(bar, b.x, nloc, nx); b.st[0] = nloc; b.st[1] = nx; }
        const unsigned old = xb_add(&bar[XB_XSUB(b.x)], 1u);
        const unsigned gen = old / nloc;
        if (old + 1u == (gen + 1u) * nloc) {
            __builtin_amdgcn_fence(__ATOMIC_RELEASE, "agent");
            asm volatile("s_waitcnt vmcnt(0)" ::: "memory");
            const unsigned og = xb_add(&bar[XB_TOP], 1u);
            const unsigned tg = og / nx;
            if (og + 1u == (tg + 1u) * nx) xb_add(&bar[XB_TOPGEN], 1u);
            else XB_SPIN(xb_ld(&bar[XB_TOPGEN]) == tg, bar);
            __builtin_amdgcn_fence(__ATOMIC_ACQUIRE, "agent");
            xb_add(&bar[XB_XGEN(b.x)], 1u);
            asm volatile("s_waitcnt vmcnt(0)" ::: "memory");
        } else {
            XB_SPIN(xb_ld(&bar[XB_XGEN(b.x)]) == gen, bar);
            __builtin_amdgcn_fence(__ATOMIC_ACQUIRE, "agent");
            asm volatile("s_waitcnt vmcnt(0)" ::: "memory");
        }
    }
    __syncthreads();
}

__device__ __forceinline__ unsigned f2bf(float f) { unsigned u = __builtin_bit_cast(unsigned, f); return (u + 0x7fffu + ((u >> 16) & 1u)) >> 16; }
__device__ __forceinline__ unsigned pk2(float lo, float hi) { return pg8::cvt_pk_bf16(lo, hi); }
__device__ __forceinline__ float bflo(unsigned u) { return __uint_as_float(u << 16); }
__device__ __forceinline__ float bfhi(unsigned u) { return __uint_as_float(u & 0xffff0000u); }
__device__ __forceinline__ float ex2(float x) { return __builtin_amdgcn_exp2f(x); }
__device__ __forceinline__ float gelu_tanh(float x) {
    const float z = 0.7978845608028654f * (x + 0.044715f * x * x * x);
    return x * __builtin_amdgcn_rcpf(1.f + ex2(-2.f * LOG2E * z));
}

struct EpiRes {
    static constexpr bool PERM = true, AFTER_DRAIN = false;
    const float* res; float* out; const f32x2* stats; const float* g; const float* bta;
    __device__ __forceinline__ void operator()(const pg8::f32x4 (&acc)[2][2][4][2], const pg8::Unit& u, int wr, int wc, int fr, int fq) const {
        const int row0 = u.pm * 256 + wr * 64 + fr, col0 = u.pn * 256 + wc * 32 + 8 * fq;
#pragma unroll
        for (int bj = 0; bj < 2; ++bj) {
            f32x4 g0 = {ALPHA, ALPHA, ALPHA, ALPHA}, g1 = g0, b0 = {0.f, 0.f, 0.f, 0.f}, b1 = b0;
            if (stats) { g0 = *(const f32x4*)(g + col0 + bj * 128) * ALPHA; g1 = *(const f32x4*)(g + col0 + bj * 128 + 4) * ALPHA; b0 = *(const f32x4*)(bta + col0 + bj * 128) * ALPHA; b1 = *(const f32x4*)(bta + col0 + bj * 128 + 4) * ALPHA; }
#pragma unroll
            for (int ai = 0; ai < 2; ++ai)
#pragma unroll
                for (int m = 0; m < 4; ++m) { const int row = row0 + ai * 128 + m * 16; const size_t off = (size_t)row * DM + col0 + bj * 128;
                    f32x4 r0 = *(const f32x4*)(res + off), r1 = *(const f32x4*)(res + off + 4);
                    if (stats) { const f32x2 st = stats[row]; r0 = (r0 - st.x) * st.y; r1 = (r1 - st.x) * st.y; }
                    *(f32x4*)(out + off) = r0 * g0 + b0 + acc[ai][bj][m][0]; *(f32x4*)(out + off + 4) = r1 * g1 + b1 + acc[ai][bj][m][1]; }
        }
    }
};
__device__ __forceinline__ float q4_sum(float v) {
    auto a = __builtin_amdgcn_permlane16_swap(__float_as_uint(v), __float_as_uint(v), false, false); v = __uint_as_float(a[0]) + __uint_as_float(a[1]);
    auto c = __builtin_amdgcn_permlane32_swap(__float_as_uint(v), __float_as_uint(v), false, false); return __uint_as_float(c[0]) + __uint_as_float(c[1]);
}
struct EpiInProj {
    static constexpr bool PERM = true, AFTER_DRAIN = false;
    bf16* O; const f32x2* tab; LAS float* T; const float* bqg; const float* bkg; const float* clg; const float* clb;
    __device__ __forceinline__ void operator()(const pg8::f32x4 (&acc)[2][2][4][2], const pg8::Unit& u, int wr, int wc, int fr, int fq) const {
        int fr_ = fr, fq_ = fq; asm volatile("" : "+v"(fr_), "+v"(fq_));
        fr = fr_; fq = fq_;
        const int rl0 = wr * 64 + fr, row0 = u.pm * 256 + rl0, col0 = u.pn * 256 + wc * 32 + 8 * fq;
        const int pn = u.pn;
        LAS float* const Tw = T + rl0 * 8 + wc; LAS float* const Tx = T + rl0 * 8 + (wc ^ 1); LAS float* const Tr = T + rl0 * 8;
        const bool lowh = fq < 2; const int i0 = 8 * (fq & 1);
        if (pn <= 2 || pn == 6) {
            const int mode = pn <= 1 ? 1 : (pn == 6 ? 2 : 0);
            const float sc = pn == 0 ? SCALE_A : 1.f;
#pragma unroll
            for (int ai = 0; ai < 2; ++ai)
#pragma unroll
                for (int m = 0; m < 4; ++m) { const int row = row0 + ai * 128 + m * 16; bf16* rowp = O + (size_t)row * INC + col0;
                    f32x4 cs[4] = {};
                    if (mode == 1) { const f32x4* tp = (const f32x4*)(tab + (row & (SEQ - 1)) * 16 + i0);
#pragma unroll
                        for (int k = 0; k < 4; ++k) cs[k] = tp[k]; }
#pragma unroll
                    for (int bj = 0; bj < 2; ++bj) { float v[8];
#pragma unroll
                        for (int n = 0; n < 2; ++n)
#pragma unroll
                            for (int j = 0; j < 4; ++j) v[4 * n + j] = acc[ai][bj][m][n][j];
                        if (mode == 2) {
#pragma unroll
                            for (int j = 0; j < 8; ++j) v[j] = gelu_tanh(v[j]);
                        } else if (mode == 1) {
#pragma unroll
                            for (int j = 0; j < 8; ++j) { auto rr = __builtin_amdgcn_permlane32_swap(__float_as_uint(v[j]), __float_as_uint(v[j]), false, false);
                                const float pr = __uint_as_float(lowh ? rr[1] : rr[0]);
                                const float c = cs[j >> 1][2 * (j & 1)], s = cs[j >> 1][2 * (j & 1) + 1];
                                v[j] = (lowh ? v[j] * c - pr * s : v[j] * c + pr * s) * sc; }
                        }
                        u32x4 w; w.x = pk2(v[0], v[1]); w.y = pk2(v[2], v[3]); w.z = pk2(v[4], v[5]); w.w = pk2(v[6], v[7]);
                        *(u32x4*)(rowp + bj * 128) = w; }
                    asm volatile("" ::: "memory"); }
        } else if (pn == 7) {
#pragma unroll
            for (int ai = 0; ai < 2; ++ai)
#pragma unroll
                for (int m = 0; m < 4; ++m) { float s = 0.f, ss = 0.f;
#pragma unroll
                    for (int bj = 0; bj < 2; ++bj)
#pragma unroll
                        for (int j = 0; j < 8; ++j) { const float x = gelu_tanh(acc[ai][bj][m][j >> 2][j & 3]); s += x; ss += x * x; }
                    s = q4_sum(s); ss = q4_sum(ss);
                    if (fq == 0) { Tw[(ai * 128 + m * 16) * 8 + wc] = s; Tw[(ai * 128 + m * 16) * 8 + wc + 1] = ss; }
                    }
            asm volatile("s_waitcnt lgkmcnt(0)" ::: "memory"); __builtin_amdgcn_s_barrier(); asm volatile("" ::: "memory");
            const int c0 = wc * 32 + 8 * fq;
#pragma unroll
            for (int ai = 0; ai < 2; ++ai)
#pragma unroll
                for (int m = 0; m < 4; ++m) { const int rl = rl0 + ai * 128 + m * 16; const LAS f32x4* tp = (const LAS f32x4*)(Tr + (ai * 128 + m * 16) * 8); const f32x4 t0 = tp[0], t1 = tp[1];
                    const float mu = (t0.x + t0.z + t1.x + t1.z) * (1.f / 256.f), ex2v = (t0.y + t0.w + t1.y + t1.w) * (1.f / 256.f);
                    const float rstd = 1.f / sqrtf(fmaxf(ex2v - mu * mu, 0.f) + LN_EPS);
                    bf16* rowp = O + (size_t)(u.pm * 256 + rl) * INC + col0;
#pragma unroll
                    for (int bj = 0; bj < 2; ++bj) { float v[8];
                        const f32x4 g0 = *(const f32x4*)(clg + c0 + bj * 128), g1 = *(const f32x4*)(clg + c0 + bj * 128 + 4), b0 = *(const f32x4*)(clb + c0 + bj * 128), b1 = *(const f32x4*)(clb + c0 + bj * 128 + 4);
#pragma unroll
                        for (int j = 0; j < 4; ++j) { float a0_ = acc[ai][bj][m][0][j], a1_ = acc[ai][bj][m][1][j]; asm volatile("" : "+v"(a0_), "+v"(a1_));
                            v[j] = (gelu_tanh(a0_) - mu) * rstd * g0[j] + b0[j]; v[4 + j] = (gelu_tanh(a1_) - mu) * rstd * g1[j] + b1[j]; }
                        u32x4 w; w.x = pk2(v[0], v[1]); w.y = pk2(v[2], v[3]); w.z = pk2(v[4], v[5]); w.w = pk2(v[6], v[7]);
                        *(u32x4*)(rowp + bj * 128) = w; }
                    asm volatile("" ::: "memory"); }
        } else {
#pragma unroll
            for (int ai = 0; ai < 2; ++ai)
#pragma unroll
                for (int m = 0; m < 4; ++m)
#pragma unroll
                    for (int bj = 0; bj < 2; ++bj) { float ss = 0.f;
#pragma unroll
                        for (int j = 0; j < 8; ++j) { const float x = acc[ai][bj][m][j >> 2][j & 3]; ss += x * x; }
                        ss = q4_sum(ss);
                        if (fq == 0) Tw[(ai * 128 + m * 16) * 8 + bj * 4] = ss;
                        }
            asm volatile("s_waitcnt lgkmcnt(0)" ::: "memory"); __builtin_amdgcn_s_barrier(); asm volatile("" ::: "memory");
            const int half = wc & 1; const float* gsrc = (pn == 5 ? bkg : bqg) + 32 * half + 8 * fq;
            const f32x4 g0 = *(const f32x4*)gsrc, g1 = *(const f32x4*)(gsrc + 4);
            const float sc = pn == 5 ? 1.f : SCALE_B;
#pragma unroll
            for (int ai = 0; ai < 2; ++ai)
#pragma unroll
                for (int m = 0; m < 4; ++m) { const int rl = rl0 + ai * 128 + m * 16, row = u.pm * 256 + rl, t = row & (SEQ - 1); bf16* rowp = O + (size_t)row * INC + col0;
                    const int pos = half ? (t & 63) : (t >> 6);
                    const f32x4* tp = (const f32x4*)(tab + pos * 16 + i0); f32x4 cs[4];
#pragma unroll
                    for (int k = 0; k < 4; ++k) cs[k] = tp[k];
#pragma unroll
                    for (int bj = 0; bj < 2; ++bj) { float v[8];
#pragma unroll
                        for (int j = 0; j < 8; ++j) v[j] = acc[ai][bj][m][j >> 2][j & 3];
                        if (pn != 5 || bj == 0) {
                            const float tot = Tw[(ai * 128 + m * 16) * 8 + bj * 4] + Tx[(ai * 128 + m * 16) * 8 + bj * 4];
                            const float rs = 1.f / sqrtf(tot * (1.f / 64.f) + LN_EPS);
#pragma unroll
                            for (int j = 0; j < 4; ++j) { v[j] *= rs * g0[j]; v[4 + j] *= rs * g1[j]; }
#pragma unroll
                            for (int j = 0; j < 8; ++j) { auto rr = __builtin_amdgcn_permlane32_swap(__float_as_uint(v[j]), __float_as_uint(v[j]), false, false);
                                const float pr = __uint_as_float(lowh ? rr[1] : rr[0]);
                                const float c = cs[j >> 1][2 * (j & 1)], s = cs[j >> 1][2 * (j & 1) + 1];
                                v[j] = (lowh ? v[j] * c - pr * s : v[j] * c + pr * s) * sc; }
                        }
                        u32x4 w; w.x = pk2(v[0], v[1]); w.y = pk2(v[2], v[3]); w.z = pk2(v[4], v[5]); w.w = pk2(v[6], v[7]);
                        *(u32x4*)(rowp + bj * 128) = w; }
                    asm volatile("" ::: "memory"); }
        }
    }
};
struct EpiSwiglu {
    static constexpr bool PERM = true, AFTER_DRAIN = false;
    bf16* O;
    __device__ __forceinline__ void operator()(const pg8::f32x4 (&acc)[2][2][4][2], const pg8::Unit& u, int wr, int wc, int fr, int fq) const {
        const int row0 = u.pm * 256 + wr * 64 + fr, col0 = u.pn * 128 + wc * 32 + 8 * fq;
#pragma unroll
        for (int ai = 0; ai < 2; ++ai)
#pragma unroll
            for (int m = 0; m < 4; ++m) { float v[8];
#pragma unroll
                for (int n = 0; n < 2; ++n)
#pragma unroll
                    for (int j = 0; j < 4; ++j) { const float g = acc[ai][0][m][n][j], up = acc[ai][1][m][n][j]; v[4 * n + j] = g * __builtin_amdgcn_rcpf(1.f + ex2(-LOG2E * g)) * up; }
                u32x4 w; w.x = pk2(v[0], v[1]); w.y = pk2(v[2], v[3]); w.z = pk2(v[4], v[5]); w.w = pk2(v[6], v[7]);
                *(u32x4*)(O + (size_t)(row0 + ai * 128 + m * 16) * FFH + col0) = w; }
    }
};

__device__ __forceinline__ void transpose_item(const float* __restrict__ W, int K, int N, bf16* __restrict__ WT, int k0, int n0, int drow0, LAS float* scr, int lane) {
#pragma unroll 16
    for (int i = 0; i < 32; ++i) { const int kk = 2 * i + (lane >> 5); scr[kk * 33 + (lane & 31)] = W[(size_t)(k0 + kk) * N + n0 + (lane & 31)]; }
    asm volatile("s_waitcnt lgkmcnt(0)" ::: "memory");
    const int c = lane & 7;
#pragma unroll
    for (int j = 0; j < 4; ++j) { const int n = (lane >> 3) + 8 * j; const LAS float* s = scr + (8 * c) * 33 + n;
        u32x4 o; o.x = pk2(s[0 * 33], s[1 * 33]); o.y = pk2(s[2 * 33], s[3 * 33]); o.z = pk2(s[4 * 33], s[5 * 33]); o.w = pk2(s[6 * 33], s[7 * 33]);
        *(u32x4*)(WT + (size_t)(drow0 + n) * K + k0 + 8 * c) = o; }
    asm volatile("s_waitcnt lgkmcnt(0)" ::: "memory");
}

struct Args { const float* in[18]; float* out; unsigned char* ws; };
struct Ctx {
    const float* const* in; float* out; unsigned char* ws;
    int tid, lane, wave, vcu, G;
};

__device__ __forceinline__ void p0_prologue(const Ctx& F, LAS unsigned char* lds) {
    LAS float* scr = (LAS float*)(lds + F.wave * 16384);
    const int gw = F.vcu * 8 + F.wave, NGW = F.G * 8;
    constexpr int PER_LAYER = 1024 + 512 + 1408 + 1408 + 1408;
    for (int it = gw; it < DEPTH * PER_LAYER; it += NGW) {
        const int l = it / PER_LAYER; int r = it % PER_LAYER;
        unsigned char* wl = F.ws + WS_W + (size_t)l * W_LAYER;
        if (r < 1024) { const int kb = r / 64, nb = r % 64; transpose_item(F.in[1] + (size_t)l * DM * INC, DM, INC, (bf16*)(wl + W_IN), 64 * kb, 32 * nb, 32 * nb, scr, F.lane); continue; }
        r -= 1024;
        if (r < 512) { const int kb = r / 32, nb = r % 32; transpose_item(F.in[2] + (size_t)l * DM * DM, DM, DM, (bf16*)(wl + W_O), 64 * kb, 32 * nb, 32 * nb, scr, F.lane); continue; }
        r -= 512;
        if (r < 1408) { const int kb = r / 88, nb = r % 88, n0 = 32 * nb; transpose_item(F.in[13] + (size_t)l * DM * FFH, DM, FFH, (bf16*)(wl + W_GU), 64 * kb, n0, 256 * (n0 / 128) + (n0 % 128), scr, F.lane); continue; }
        r -= 1408;
        if (r < 1408) { const int kb = r / 88, nb = r % 88, n0 = 32 * nb; transpose_item(F.in[14] + (size_t)l * DM * FFH, DM, FFH, (bf16*)(wl + W_GU), 64 * kb, n0, 256 * (n0 / 128) + 128 + (n0 % 128), scr, F.lane); continue; }
        r -= 1408;
        { const int kb = r / 32, nb = r % 32; transpose_item(F.in[15] + (size_t)l * FFH * DM, FFH, DM, (bf16*)(wl + W_D), 64 * kb, 32 * nb, 32 * nb, scr, F.lane); }
    }
    const float* x = F.in[0]; bf16* xb = (bf16*)(F.ws + WS_XB);
    for (int m0 = gw * 4; m0 < MROWS; m0 += NGW * 4) {
        f32x4 v[4][4];
#pragma unroll
        for (int i = 0; i < 4; ++i) { const f32x4* xr = (const f32x4*)(x + (size_t)(m0 + i) * DM) + F.lane;
#pragma unroll
            for (int j = 0; j < 4; ++j) v[i][j] = xr[64 * j]; }
#pragma unroll
        for (int i = 0; i < 4; ++i) { u32x2* o8 = (u32x2*)(xb + (size_t)(m0 + i) * DM) + F.lane;
#pragma unroll
            for (int j = 0; j < 4; ++j) { u32x2 w; w.x = pk2(v[i][j].x, v[i][j].y); w.y = pk2(v[i][j].z, v[i][j].w); o8[64 * j] = w; } }
    }
    const int gt = F.vcu * NT + F.tid, NGT = F.G * NT;
    f32x2* tab = (f32x2*)(F.ws + WS_TAB);
    for (int e = gt; e < 2048 * 16; e += NGT) { const int pos = e >> 4, i = e & 15;
        const float inv = 1.0f / powf(10000.0f, (float)i * (1.0f / 16.0f)); const float ang = (float)pos * inv;
        tab[e] = (f32x2){cosf(ang), sinf(ang)}; }
    bf16* wsb = (bf16*)(F.ws + WS_WSB); const float* cws = F.in[9];
    for (int e = gt; e < DEPTH * 4 * 128 * 128; e += NGT) wsb[e] = (bf16)f2bf(cws[e]);
}

__device__ __forceinline__ void p1b_postproc(const Ctx& F, int l) {
    int lane_ = F.lane; asm volatile("" : "+v"(lane_));
    const int gw = F.vcu * 8 + F.wave, NGW = F.G * 8, sidx = lane_ & 31, rsel = lane_ >> 5;
    bf16* h = (bf16*)(F.ws + WS_H);
    const f32x2* tab = (const f32x2*)(F.ws + WS_TAB);
    const float* bqg = F.in[5] + l * 64; const float* bkg = F.in[6] + l * 64; const float* clg = F.in[7] + l * 256; const float* clb = F.in[8] + l * 256;
    const bool isB = sidx < 20, isCv = sidx >= 24, act = isB || isCv;
    const int seg = isB ? 24 + sidx : 32 + sidx;
    const int half = sidx & 1;
    const float* gsrc = (sidx < 16 ? bqg : bkg) + 32 * half;
    const float scale = sidx < 16 ? SCALE_B : 1.f;
    const int c0 = 32 * (sidx & 7);
    for (int m0 = gw * 8; m0 < MROWS; m0 += NGW * 8) {
      u32x4 rawv[4][4];
#pragma unroll
      for (int i = 0; i < 4; ++i) { const u32x4* p_ = (const u32x4*)(h + (size_t)(m0 + 2 * i + rsel) * INC + 32 * seg);
          if (act) {
#pragma unroll
              for (int k = 0; k < 4; ++k) rawv[i][k] = p_[k];
          } else {
#pragma unroll
              for (int k = 0; k < 4; ++k) rawv[i][k] = (u32x4){0u, 0u, 0u, 0u};
          } }
#pragma unroll
      for (int i4 = 0; i4 < 4; ++i4) {
        const int m = m0 + 2 * i4 + rsel;
        const int t = m & (SEQ - 1);
        u32x4* p = (u32x4*)(h + (size_t)m * INC + 32 * seg);
        float v[32];
#pragma unroll
        for (int k = 0; k < 4; ++k) { const u32x4 raw = rawv[i4][k];
            v[8 * k + 0] = bflo(raw.x); v[8 * k + 1] = bfhi(raw.x); v[8 * k + 2] = bflo(raw.y); v[8 * k + 3] = bfhi(raw.y);
            v[8 * k + 4] = bflo(raw.z); v[8 * k + 5] = bfhi(raw.z); v[8 * k + 6] = bflo(raw.w); v[8 * k + 7] = bfhi(raw.w); }
        float s = 0.f, ss = 0.f;
#pragma unroll
        for (int i = 0; i < 32; ++i) { s += v[i]; ss += v[i] * v[i]; }
        const float ss2 = ss + __shfl_xor(ss, 1);
        float s8 = s; s8 += __shfl_xor(s8, 1); s8 += __shfl_xor(s8, 2); s8 += __shfl_xor(s8, 4);
        const float mu = s8 * (1.f / 256.f);
        float dq = 0.f;
#pragma unroll
        for (int i = 0; i < 32; ++i) { const float d = v[i] - mu; dq += d * d; }
        dq += __shfl_xor(dq, 1); dq += __shfl_xor(dq, 2); dq += __shfl_xor(dq, 4);
        const float rstd = 1.f / sqrtf(dq * (1.f / 256.f) + LN_EPS);
        if (isCv) {
#pragma unroll
            for (int i = 0; i < 32; ++i) v[i] = (v[i] - mu) * rstd * clg[c0 + i] + clb[c0 + i];
        } else if (isB) {
            const float rs = 1.f / sqrtf(ss2 * (1.f / 64.f) + LN_EPS);
#pragma unroll
            for (int i = 0; i < 32; ++i) v[i] = v[i] * rs * gsrc[i];
            const int pos = half ? (t & 63) : (t >> 6);
            const f32x2* tp = tab + pos * 16;
#pragma unroll
            for (int i = 0; i < 16; ++i) { const f32x2 cs = tp[i]; const float x1 = v[i], x2 = v[i + 16];
                v[i] = (x1 * cs.x - x2 * cs.y) * scale; v[i + 16] = (x2 * cs.x + x1 * cs.y) * scale; }
        }
        if (act) {
#pragma unroll
            for (int k = 0; k < 4; ++k) { u32x4 w; w.x = pk2(v[8 * k + 0], v[8 * k + 1]); w.y = pk2(v[8 * k + 2], v[8 * k + 3]); w.z = pk2(v[8 * k + 4], v[8 * k + 5]); w.w = pk2(v[8 * k + 6], v[8 * k + 7]); p[k] = w; }
        }
      }
    }
}

template <bool FINAL>
__device__ __forceinline__ void ln_pass(const Ctx& F, const float* __restrict__ g, const float* __restrict__ bta) {
    int lane_ = F.lane; asm volatile("" : "+v"(lane_));
    const int gw = F.vcu * 8 + F.wave, NGW = F.G * 8;
    float* X = F.out; bf16* xb = (bf16*)(F.ws + WS_XB); f32x2* stats = (f32x2*)(F.ws + WS_STATS);
    f32x4 gv[4], bv[4];
#pragma unroll
    for (int j = 0; j < 4; ++j) { gv[j] = ((const f32x4*)g)[lane_ + 64 * j]; bv[j] = ((const f32x4*)bta)[lane_ + 64 * j]; }
    for (int m0 = gw * 4; m0 < MROWS; m0 += NGW * 4) {
        f32x4 v[4][4];
#pragma unroll
        for (int i = 0; i < 4; ++i) { const f32x4* xr = (const f32x4*)(X + (size_t)(m0 + i) * DM) + lane_;
#pragma unroll
            for (int j = 0; j < 4; ++j) v[i][j] = xr[64 * j]; }
#pragma unroll
        for (int i = 0; i < 4; ++i) {
            float s = 0.f;
#pragma unroll
            for (int j = 0; j < 4; ++j) s += (v[i][j].x + v[i][j].y) + (v[i][j].z + v[i][j].w);
#pragma unroll
            for (int o = 1; o < 64; o <<= 1) s += __shfl_xor(s, o);
            const float mean = s * (1.f / DM); float s2 = 0.f;
#pragma unroll
            for (int j = 0; j < 4; ++j) { v[i][j] = v[i][j] - mean; s2 += (v[i][j].x * v[i][j].x + v[i][j].y * v[i][j].y) + (v[i][j].z * v[i][j].z + v[i][j].w * v[i][j].w); }
#pragma unroll
            for (int o = 1; o < 64; o <<= 1) s2 += __shfl_xor(s2, o);
            const float rstd = 1.f / sqrtf(s2 * (1.f / DM) + LN_EPS);
            if constexpr (FINAL) { f32x4* xr = (f32x4*)(X + (size_t)(m0 + i) * DM) + lane_;
#pragma unroll
                for (int j = 0; j < 4; ++j) xr[64 * j] = v[i][j] * rstd * gv[j] + bv[j];
            } else { u32x2* o8 = (u32x2*)(xb + (size_t)(m0 + i) * DM) + lane_;
#pragma unroll
                for (int j = 0; j < 4; ++j) { const f32x4 y = v[i][j] * rstd * gv[j] + bv[j]; u32x2 w; w.x = pk2(y.x, y.y); w.y = pk2(y.z, y.w); o8[64 * j] = w; }
                if (lane_ == 0) stats[m0 + i] = (f32x2){mean, rstd}; }
        }
    }
}

constexpr int KP = 144, VP = 272;
constexpr int VG = 8 * VP + 16;
constexpr int KT_BYTES = 128 * KP, VT_BYTES = 8 * VG, STG_BYTES = KT_BYTES + VT_BYTES;
constexpr int LDS_COMB = 2 * STG_BYTES;
constexpr float RESC_THR = 8.f;
__device__ __forceinline__ float max3f(float a, float b, float c) { return fmaxf(fmaxf(a, b), c); }
__device__ __forceinline__ float xh_max(float v) { auto rr = __builtin_amdgcn_permlane32_swap(__float_as_uint(v), __float_as_uint(v), false, false); return fmaxf(__uint_as_float(rr[0]), __uint_as_float(rr[1])); }
__device__ __forceinline__ float xh_sum(float v) { auto rr = __builtin_amdgcn_permlane32_swap(__float_as_uint(v), __float_as_uint(v), false, false); return __uint_as_float(rr[0]) + __uint_as_float(rr[1]); }
template <bool DIFF>
__device__ __forceinline__ void attn_unit(LAS unsigned char* lds, const bf16* __restrict__ h, bf16* __restrict__ cat,
                                          int b, int row0, int qoff, int koff, int voff, int ooff, float lam, float oscale, const float* __restrict__ subg) {
    constexpr int NQK = DIFF ? 2 : 4;
    int tid_ = threadIdx.x; asm volatile("" : "+v"(tid_));
    const int tid = tid_, lane = tid & 63, wid = __builtin_amdgcn_readfirstlane(tid >> 6), r32 = lane & 31, hi = lane >> 5;
    const int wq = DIFF ? (wid & 3) : wid, comp = DIFF ? (wid >> 2) : 0;
    const size_t rowbase = (size_t)b * SEQ;
    const size_t qrow = rowbase + row0 + wq * 64 + r32;
    bf16x8 qf[2][NQK];
#pragma unroll
    for (int qb = 0; qb < 2; ++qb)
#pragma unroll
        for (int d0 = 0; d0 < NQK; ++d0) qf[qb][d0] = *(const bf16x8*)(h + (qrow + 32 * qb) * INC + qoff + 32 * comp + 16 * d0 + 8 * hi);
    const int srow = tid >> 3, sch = tid & 7;
    const bf16* kp = h + (rowbase + srow) * INC + koff + sch * 8;
    const bf16* vp = h + (rowbase + srow) * INC + voff + sch * 8;
    const int kwoff = srow * KP + sch * 16;
    const int vwoff = KT_BYTES + sch * VG + srow * 2;
    const int kroff = r32 * KP + hi * 16 + comp * 64;
    const int vroff = KT_BYTES + (r32 >> 3) * VG + (r32 & 7) * VP + hi * 8;
    u32x4 kr0, kr1, vr0, vr1;
#define ATT_LOAD(t) do { kr0 = *(const u32x4*)(kp + (size_t)(t) * 128 * INC); kr1 = *(const u32x4*)(kp + ((size_t)(t) * 128 + 64) * INC); \
                         vr0 = *(const u32x4*)(vp + (size_t)(t) * 128 * INC); vr1 = *(const u32x4*)(vp + ((size_t)(t) * 128 + 64) * INC); } while (0)
#define ATT_STAGE(buf) do { LAS unsigned char* sb_ = lds + (buf) * STG_BYTES; *(LAS u32x4*)(sb_ + kwoff) = kr0; *(LAS u32x4*)(sb_ + kwoff + 64 * KP) = kr1; \
        _Pragma("unroll") for (int i_ = 0; i_ < 8; ++i_) { *(LAS unsigned short*)(sb_ + vwoff + i_ * VP) = (unsigned short)(vr0[i_ >> 1] >> (16 * (i_ & 1))); \
                                                          *(LAS unsigned short*)(sb_ + vwoff + i_ * VP + 128) = (unsigned short)(vr1[i_ >> 1] >> (16 * (i_ & 1))); } } while (0)
    ATT_LOAD(0);
    ATT_STAGE(0);
    __syncthreads();
    f32x16 o[2][2]; float mref[2], lsum[2];
#pragma unroll
    for (int qb = 0; qb < 2; ++qb) { mref[qb] = -1e30f; lsum[qb] = 0.f;
#pragma unroll
        for (int db = 0; db < 2; ++db)
#pragma unroll
            for (int r = 0; r < 16; ++r) o[qb][db][r] = 0.f; }
    __builtin_amdgcn_s_waitcnt(0x0F70);
    for (int t = 0; t < SEQ / 128; ++t) {
        const int buf = t & 1;
        if (t + 1 < SEQ / 128) ATT_LOAD(t + 1);
        const LAS unsigned char* sbase = lds + buf * STG_BYTES;
        bf16x8 kfr[2][NQK], vfr[2][2];
#define LOAD_K(SET, BLK4) do { const LAS unsigned char* kb_ = sbase + kroff + (BLK4) * 32 * KP; \
            _Pragma("unroll") for (int d0 = 0; d0 < NQK; ++d0) kfr[SET][d0] = *(const LAS bf16x8*)(kb_ + d0 * 32); } while (0)
#define LOAD_V(BLK4) do { const LAS unsigned char* vb_ = sbase + vroff + (BLK4) * 64; \
            _Pragma("unroll") for (int db = 0; db < 2; ++db) _Pragma("unroll") for (int ss = 0; ss < 2; ++ss) { const LAS unsigned char* a_ = vb_ + db * 4 * VG + ss * 32; \
                const u32x2 lo_ = *(const LAS u32x2*)a_, hh_ = *(const LAS u32x2*)(a_ + 16); vfr[db][ss] = __builtin_bit_cast(bf16x8, (u32x4){lo_.x, lo_.y, hh_.x, hh_.y}); } } while (0)
        LOAD_K(0, 0);
#pragma unroll
        for (int b4 = 0; b4 < 4; ++b4) {
            const int cur = b4 & 1;
            LOAD_V(b4);
            if (b4 < 3) { if (cur == 0) LOAD_K(1, b4 + 1); else LOAD_K(0, b4 + 1); }
            f32x16 s[2];
#pragma unroll
            for (int qb = 0; qb < 2; ++qb)
#pragma unroll
                for (int r = 0; r < 16; ++r) s[qb][r] = 0.f;
#pragma unroll
            for (int d0 = 0; d0 < NQK; ++d0) {
                s[0] = __builtin_amdgcn_mfma_f32_32x32x16_bf16(kfr[cur][d0], qf[0][d0], s[0], 0, 0, 0);
                s[1] = __builtin_amdgcn_mfma_f32_32x32x16_bf16(kfr[cur][d0], qf[1][d0], s[1], 0, 0, 0); }
            bf16x8 pf[2][2];
#pragma unroll
            for (int qb = 0; qb < 2; ++qb) {
                float ma = max3f(s[qb][0], s[qb][1], s[qb][2]), mb = max3f(s[qb][3], s[qb][4], s[qb][5]);
                ma = max3f(ma, s[qb][6], s[qb][7]); mb = max3f(mb, s[qb][8], s[qb][9]); ma = max3f(ma, s[qb][10], s[qb][11]); mb = max3f(mb, s[qb][12], s[qb][13]); ma = max3f(ma, s[qb][14], s[qb][15]);
                const float mx = xh_max(fmaxf(ma, mb));
                if (__any(mx > mref[qb] + RESC_THR)) {
                    const float nm = fmaxf(mx, mref[qb]), f = ex2(mref[qb] - nm); mref[qb] = nm; lsum[qb] *= f;
#pragma unroll
                    for (int db = 0; db < 2; ++db)
#pragma unroll
                        for (int r = 0; r < 16; ++r) o[qb][db][r] *= f;
                }
                const float mr = mref[qb]; float sum = 0.f;
#pragma unroll
                for (int r = 0; r < 16; ++r) { const float p = ex2(s[qb][r] - mr); s[qb][r] = p; sum += p; }
                lsum[qb] += sum;
#pragma unroll
                for (int ss = 0; ss < 2; ++ss)
                    pf[qb][ss] = __builtin_bit_cast(bf16x8, (u32x4){pk2(s[qb][8 * ss + 0], s[qb][8 * ss + 1]), pk2(s[qb][8 * ss + 2], s[qb][8 * ss + 3]), pk2(s[qb][8 * ss + 4], s[qb][8 * ss + 5]), pk2(s[qb][8 * ss + 6], s[qb][8 * ss + 7])});
            }
#pragma unroll
            for (int db = 0; db < 2; ++db)
#pragma unroll
                for (int ss = 0; ss < 2; ++ss) {
                    o[0][db] = __builtin_amdgcn_mfma_f32_32x32x16_bf16(vfr[db][ss], pf[0][ss], o[0][db], 0, 0, 0);
                    o[1][db] = __builtin_amdgcn_mfma_f32_32x32x16_bf16(vfr[db][ss], pf[1][ss], o[1][db], 0, 0, 0); }
        }
#undef LOAD_K
#undef LOAD_V
        if (t + 1 < SEQ / 128) ATT_STAGE(buf ^ 1);
        __syncthreads();
    }
#undef ATT_LOAD
#undef ATT_STAGE
#pragma unroll
    for (int qb = 0; qb < 2; ++qb) { const float lt = xh_sum(lsum[qb]); const float inv = 1.f / lt;
#pragma unroll
        for (int db = 0; db < 2; ++db)
#pragma unroll
            for (int r = 0; r < 16; ++r) o[qb][db][r] *= inv; }
    float rs[2] = {1.f, 1.f};
    if constexpr (DIFF) {
        LAS float* X = (LAS float*)(lds + LDS_COMB) + (wq * 64) * 64 + lane;
        if (comp == 1) {
#pragma unroll
            for (int qb = 0; qb < 2; ++qb)
#pragma unroll
                for (int db = 0; db < 2; ++db)
#pragma unroll
                    for (int r = 0; r < 16; ++r) X[((qb * 2 + db) * 16 + r) * 64] = o[qb][db][r];
        }
        __syncthreads();
        if (comp == 1) return;
#pragma unroll
        for (int qb = 0; qb < 2; ++qb) { float ss = 0.f;
#pragma unroll
            for (int db = 0; db < 2; ++db)
#pragma unroll
                for (int r = 0; r < 16; ++r) { const float x = o[qb][db][r] - lam * X[((qb * 2 + db) * 16 + r) * 64]; o[qb][db][r] = x; ss += x * x; }
            ss = xh_sum(ss);
            rs[qb] = oscale / sqrtf(ss * (1.f / 64.f) + LN_EPS); }
    }
#pragma unroll
    for (int qb = 0; qb < 2; ++qb) { bf16* op = cat + (qrow + 32 * qb) * DM + ooff;
#pragma unroll
        for (int db = 0; db < 2; ++db)
#pragma unroll
            for (int r4 = 0; r4 < 4; ++r4) { const int d = 32 * db + 8 * r4 + 4 * hi;
                float v0 = o[qb][db][4 * r4 + 0], v1 = o[qb][db][4 * r4 + 1], v2 = o[qb][db][4 * r4 + 2], v3 = o[qb][db][4 * r4 + 3];
                if constexpr (DIFF) { const f32x4 gg = *(const f32x4*)(subg + d); const float q = rs[qb]; v0 *= q * gg.x; v1 *= q * gg.y; v2 *= q * gg.z; v3 *= q * gg.w; }
                u32x2 w; w.x = pk2(v0, v1); w.y = pk2(v2, v3); *(u32x2*)(op + d) = w; } }
}

constexpr int GROW = 272, GGRP = 8 * GROW + 16;
__device__ __forceinline__ void gate_unit(LAS unsigned char* lds, const bf16* __restrict__ h, bf16* __restrict__ cat, const bf16* __restrict__ wsb, const float* __restrict__ bs, int b, int n, int g) {
    int tid_ = threadIdx.x; asm volatile("" : "+v"(tid_));
    const int tid = tid_, lane = tid & 63, wid = tid >> 6, r32 = lane & 31, hi = lane >> 5;
    const size_t R0 = (size_t)b * SEQ + n * 128;
#pragma unroll
    for (int i = 0; i < 2; ++i) { const int idx = tid + NT * i, row = idx >> 3, ch = idx & 7;
        const u32x4 v = *(const u32x4*)(h + (R0 + row) * INC + 1792 + 64 * g + ch * 8);
#pragma unroll
        for (int j = 0; j < 8; ++j) *(LAS unsigned short*)(lds + ch * GGRP + j * GROW + row * 2) = (unsigned short)(v[j >> 1] >> (16 * (j & 1))); }
    __syncthreads();
    const int pb = wid & 3, db = wid >> 2;
    f32x16 acc;
#pragma unroll
    for (int r = 0; r < 16; ++r) acc[r] = 0.f;
    const bf16* wrow = wsb + ((size_t)(g * 128 + 32 * pb + r32)) * 128 + 8 * hi;
#pragma unroll
    for (int ks = 0; ks < 8; ++ks) {
        const bf16x8 a = *(const LAS bf16x8*)(lds + (4 * db + (r32 >> 3)) * GGRP + (r32 & 7) * GROW + 32 * ks + 16 * hi);
        const bf16x8 bb = *(const bf16x8*)(wrow + 16 * ks);
        acc = __builtin_amdgcn_mfma_f32_32x32x16_bf16(a, bb, acc, 0, 0, 0);
    }
    const int p = 32 * pb + r32; const float bias = bs[g * 128 + p];
    const bf16* up = h + (R0 + p) * INC + 1536 + 64 * g; bf16* op = cat + (R0 + p) * DM + 768 + 64 * g;
#pragma unroll
    for (int r4 = 0; r4 < 4; ++r4) { const int d = 32 * db + 8 * r4 + 4 * hi; const u32x2 uu = *(const u32x2*)(up + d);
        u32x2 w; w.x = pk2(bflo(uu.x) * (acc[4 * r4 + 0] + bias), bfhi(uu.x) * (acc[4 * r4 + 1] + bias)); w.y = pk2(bflo(uu.y) * (acc[4 * r4 + 2] + bias), bfhi(uu.y) * (acc[4 * r4 + 3] + bias));
        *(u32x2*)(op + d) = w; }
    __syncthreads();
}

__device__ __forceinline__ void p2_mixers(const Ctx& F, LAS unsigned char* lds, int l, int simd_rank) {
    const bf16* h = (const bf16*)(F.ws + WS_H); bf16* cat = (bf16*)(F.ws + WS_CAT);
    const float lam_init = l == 0 ? 0.2f : l == 1 ? 0.35550907f : l == 2 ? 0.47071302f : 0.55605820f;
    const float* lq = F.in[3] + l * 128; float d1 = 0.f, d2 = 0.f;
    for (int i = 0; i < 32; ++i) { d1 += lq[i] * lq[32 + i]; d2 += lq[64 + i] * lq[96 + i]; }
    const float lam = expf(d1) - expf(d2) + lam_init;
    const float* subg = F.in[4] + l * 64;
    if (simd_rank == 0) __builtin_amdgcn_s_setprio(2);
    for (int u = F.vcu; u < BATCH * 4 * 8; u += F.G) { const int qb = u & 7, hh = (u >> 3) & 3, b = u >> 5;
        attn_unit<true>(lds, h, cat, b, qb * 256, 64 * hh, 256 + 64 * hh, 512 + 64 * hh, 64 * hh, lam, 1.f - lam_init, subg); }
    for (int u = F.vcu; u < BATCH * 8 * 4; u += F.G) { const int q4 = u & 3, j = (u >> 2) & 7, b = u >> 5;
        attn_unit<false>(lds, h, cat, b, q4 * 512, 768 + 64 * j, 1280 + 64 * (j >> 2), 1408 + 64 * (j >> 2), 256 + 64 * j, 0.f, 1.f, subg); }
    __builtin_amdgcn_s_setprio(0);
    const bf16* wsb = (const bf16*)(F.ws + WS_WSB) + (size_t)l * 4 * 128 * 128; const float* bs = F.in[10] + l * 512;
    for (int u = F.vcu; u < BATCH * 16 * 4; u += F.G) { const int g = u & 3, n = (u >> 2) & 15, b = u >> 6;
        gate_unit(lds, h, cat, wsb, bs, b, n, g); }
}

__global__ void __launch_bounds__(NT, 2) fwd_megakernel(Args args) {
    extern __shared__ __attribute__((aligned(16))) unsigned char lds_raw[];
    LAS unsigned char* lds = (LAS unsigned char*)lds_raw;
    cg::grid_group grid = cg::this_grid();
    Ctx F;
    F.in = args.in; F.out = args.out; F.ws = args.ws;
    F.tid = threadIdx.x; F.lane = F.tid & 63; F.wave = __builtin_amdgcn_readfirstlane(F.tid >> 6);
    F.G = gridDim.x; { const int bx = blockIdx.x; F.vcu = (F.G % 8 == 0) ? (bx % 8) * (F.G / 8) + bx / 8 : bx; }
    bf16* xb = (bf16*)(F.ws + WS_XB); bf16* h = (bf16*)(F.ws + WS_H); bf16* cat = (bf16*)(F.ws + WS_CAT); bf16* hid = (bf16*)(F.ws + WS_HID);

#ifndef NO_P0
    p0_prologue(F, lds);
#endif
    if (F.tid < 16) ((LAS unsigned*)(lds + MISC_OFF))[F.tid] = 0u;
    if (blockIdx.x == 0) for (int i = F.tid; i < XCD_BAR_WORDS; i += NT) __hip_atomic_store((unsigned*)(F.ws + WS_BAR) + i, 0u, __ATOMIC_RELAXED, __HIP_MEMORY_SCOPE_AGENT);
    grid.sync();
    int simd_rank;
    { const unsigned simd = (unsigned)__builtin_amdgcn_s_getreg((1 << 11) | (4 << 6) | 4) & 3u;
      unsigned r = 0; if (F.lane == 0) r = __hip_atomic_fetch_add((LAS unsigned*)(lds + MISC_OFF) + 4 + simd, 1u, __ATOMIC_RELAXED, __HIP_MEMORY_SCOPE_WORKGROUP);
      simd_rank = (int)(__builtin_amdgcn_readfirstlane(r) & 1u); }
    const XcdBarrier bar = xcd_barrier_post((unsigned*)(F.ws + WS_BAR), (volatile LAS unsigned*)(lds + MISC_OFF));
    for (int l = 0; l < DEPTH; ++l) {
        unsigned char* wl = F.ws + WS_W + (size_t)l * W_LAYER;
#ifndef NO_P1
        {
            pg8::Gemm g{xb, (const bf16*)(wl + W_IN), MROWS, INC, DM}; pg8::StaticOrder S; S.init(MROWS, INC, F.G, (int)blockIdx.x);
            EpiInProj E{h, (const f32x2*)(F.ws + WS_TAB), (LAS float*)(lds + 131072), F.in[5] + l * 64, F.in[6] + l * 64, F.in[7] + l * 256, F.in[8] + l * 256};
            pg8::gemm_phase<EpiInProj, pg8::StaticOrder, true, true>(lds, g, S, E);
        }
#endif
        xcd_barrier(bar);
#ifndef NO_P2
        p2_mixers(F, lds, l, simd_rank);
#endif
        xcd_barrier(bar);
#ifndef NO_P3
        {
            pg8::Gemm g{cat, (const bf16*)(wl + W_O), MROWS, DM, DM}; pg8::StaticOrder S; S.init(MROWS, DM, F.G, (int)blockIdx.x);
            EpiRes E{l == 0 ? F.in[0] : (const float*)F.out, F.out, l == 0 ? nullptr : (const f32x2*)(F.ws + WS_STATS), F.in[16] + (l - 1) * DM, F.in[17] + (l - 1) * DM};
            pg8::gemm_phase<EpiRes, pg8::StaticOrder, true, true>(lds, g, S, E);
        }
#endif
        xcd_barrier(bar);
#ifndef NO_LN
        ln_pass<false>(F, F.in[11] + l * DM, F.in[12] + l * DM);
#endif
        xcd_barrier(bar);
#ifndef NO_P4
        {
            pg8::Gemm g{xb, (const bf16*)(wl + W_GU), MROWS, GU, DM}; pg8::StaticOrder S; S.init(MROWS, GU, F.G, (int)blockIdx.x);
            EpiSwiglu E{hid};
            pg8::gemm_phase<EpiSwiglu, pg8::StaticOrder, true, true>(lds, g, S, E);
        }
#endif
        xcd_barrier(bar);
#ifndef NO_P5
        {
            pg8::Gemm g{hid, (const bf16*)(wl + W_D), MROWS, DM, FFH}; pg8::StaticOrder S; S.init(MROWS, DM, F.G, (int)blockIdx.x);
            EpiRes E{(const float*)F.out, F.out, (const f32x2*)(F.ws + WS_STATS), F.in[11] + l * DM, F.in[12] + l * DM};
            pg8::gemm_phase<EpiRes, pg8::StaticOrder, true, true>(lds, g, S, E);
        }
#endif
        xcd_barrier(bar);
#ifndef NO_LN
        if (l == DEPTH - 1) ln_pass<true>(F, F.in[16] + l * DM, F.in[17] + l * DM); else ln_pass<false>(F, F.in[16] + l * DM, F.in[17] + l * DM);
#endif
        xcd_barrier(bar);
    }
}

extern "C" void kernel_launch(void* const* d_in, const int* in_sizes, int n_in, void* d_out, int out_size, void* d_ws, size_t ws_size, hipStream_t stream) {
    static int grid = 0;
    if (grid == 0) {
        if (n_in != 18 || in_sizes[0] != MROWS * DM || out_size != MROWS * DM || ws_size < WS_END) { fprintf(stderr, "kernel_launch: unexpected shapes (n_in %d, ws %zu)\n", n_in, ws_size); grid = -1; return; }
        int dev = 0, cus = 0, per_cu = 0;
        hipGetDevice(&dev); hipDeviceGetAttribute(&cus, hipDeviceAttributeMultiprocessorCount, dev);
        hipFuncSetAttribute((const void*)fwd_megakernel, hipFuncAttributeMaxDynamicSharedMemorySize, LDS_BYTES);
        hipOccupancyMaxActiveBlocksPerMultiprocessor(&per_cu, (const void*)fwd_megakernel, NT, LDS_BYTES);
        if (per_cu < 1) per_cu = 1;
        (void)hipGetLastError();
        grid = cus * per_cu;
    }
    if (grid < 0) return;
    Args a{};
    for (int i = 0; i < 18; ++i) a.in[i] = (const float*)d_in[i];
    a.out = (float*)d_out; a.ws = (unsigned char*)d_ws;
    void* kargs[] = {&a};
    hipError_t e = hipLaunchCooperativeKernel((const void*)fwd_megakernel, dim3(grid), dim3(NT), kargs, LDS_BYTES, stream);
    if (e != hipSuccess) fprintf(stderr, "cooperative launch failed: %s (grid %d)\n", hipGetErrorString(e), grid);
}
```
